# Optimizing an MI355X kernel written in HIP

```python
import math
import jax, jax.numpy as jnp
from jax import lax
import numpy as np

D_MODEL = 1024
BATCH = 8
SEQ = 2048
DEPTH = 1

N_MEM = 256
H_RNN = 8
RNN_KDIM = 128
RNN_VDIM = 128
RNN_WIDTH = H_RNN * RNN_KDIM
RNN_VWIDTH = H_RNN * RNN_VDIM
RNN_CHUNK = 64
H_ATT = 16
ATT_HD = 64
G_KV = 4
HG = H_ATT // G_KV
ATT_WIDTH = H_ATT * ATT_HD
KV_WIDTH = G_KV * ATT_HD
CMP_LEN = 32
CMP_STRIDE = 16
CMP_HIDDEN = 128
SLC_LEN = 64
SLC_TOPK = 8
WINDOW = 512
Q_BLOCK = 64
FORCE_BONUS = 1.0e4
H_X = 4
X_HD = 128
D_FF = -(-8 * D_MODEL // (3 * 256)) * 256
SPLIT_SIZES = (RNN_WIDTH, RNN_WIDTH, RNN_VWIDTH, RNN_VWIDTH,
               ATT_WIDTH, 6 * KV_WIDTH, 3 * H_ATT, D_MODEL, D_MODEL)
IN_WIDTH = sum(SPLIT_SIZES)

kernel_name = "hybrid_hgrn2_nsa_gated_block"


def rms_norm(x, g, eps=1e-6):
    xf = x.astype(jnp.float32)
    y = xf * lax.rsqrt(jnp.mean(xf * xf, axis=-1, keepdims=True) + eps)
    return (y * g.astype(jnp.float32)).astype(x.dtype)


def masked_softmax(s, mask):
    s = jnp.where(mask, s.astype(jnp.float32), -jnp.inf)
    m = jnp.max(s, axis=-1, keepdims=True)
    m = jnp.where(jnp.isfinite(m), m, 0.0)
    p = jnp.exp(s - m)
    d = jnp.sum(p, axis=-1, keepdims=True)
    return p / jnp.where(d > 0, d, 1.0)


def alibi_slopes(n):
    return 2.0 ** (-8.0 * jnp.arange(1, n + 1, dtype=jnp.float32) / n)


def hgrn2(q, f_logit, inp, og, lb, g_norm):
    B, T, _ = q.shape
    C = RNN_CHUNK
    N = T // C
    f32 = jnp.float32
    lbf = lb.astype(f32)
    f = lbf + (1.0 - lbf) * jax.nn.sigmoid(f_logit.astype(f32))
    k = 1.0 - f
    logf = jnp.log(f)
    qa = jax.nn.silu(q.astype(f32))

    def chunks(t, d):
        return t.reshape(B, N, C, H_RNN, d).transpose(0, 3, 1, 2, 4)

    qc, kc, lc = chunks(qa, RNN_KDIM), chunks(k, RNN_KDIM), chunks(logf, RNN_KDIM)
    vc = chunks(inp.astype(f32), RNN_VDIM)
    b = jnp.cumsum(lc, axis=3)
    b_last = b[:, :, :, -1:, :]
    q_dec = qc * jnp.exp(b)
    k_dec = kc * jnp.exp(-b)
    k_end = kc * jnp.exp(b_last - b)
    causal = jnp.tril(jnp.ones((C, C), dtype=bool))
    A = jnp.where(causal, jnp.einsum('bhnck,bhnsk->bhncs', q_dec, k_dec), 0.0)
    o_intra = jnp.einsum('bhncs,bhnsv->bhncv', A, vc)
    U = jnp.einsum('bhnsk,bhnsv->nbhkv', k_end, vc)
    decay = jnp.exp(b_last[:, :, :, 0, :]).transpose(2, 0, 1, 3)[..., None]

    def step(S, xs):
        dec, u = xs
        return dec * S + u, S

    S0 = jnp.zeros((B, H_RNN, RNN_KDIM, RNN_VDIM), f32)
    _, S_prev = lax.scan(step, S0, (decay, U))
    o_inter = jnp.einsum('bhnck,nbhkv->bhncv', q_dec, S_prev)
    o = (o_intra + o_inter).transpose(0, 2, 3, 1, 4)
    o = rms_norm(o, g_norm) * jax.nn.silu(og.astype(f32).reshape(B, N, C, H_RNN, RNN_VDIM))
    return o.reshape(B, T, RNN_VWIDTH).astype(q.dtype)


def nsa(q, kv, gate_logits, pe_ck, w_ck1, w_ck2, pe_cv, w_cv1, w_cv2):
    B, T, _ = q.shape
    n_sel = min(SLC_TOPK, T // SLC_LEN)
    pos = jnp.arange(T)
    slopes = alibi_slopes(H_ATT).reshape(1, G_KV, HG, 1, 1)
    qh = q.reshape(B, T, G_KV, HG, ATT_HD).transpose(0, 2, 3, 1, 4) * (ATT_HD ** -0.5)
    k_c, v_c, k_s, v_s, k_w, v_w = [
        t.reshape(B, T, G_KV, ATT_HD).transpose(0, 2, 1, 3) for t in jnp.split(kv, 6, axis=-1)]

    Nc = (T - CMP_LEN) // CMP_STRIDE + 1
    starts = CMP_STRIDE * jnp.arange(Nc)
    blk_idx = starts[:, None] + jnp.arange(CMP_LEN)[None, :]

    def compress(t, pe, w1, w2):
        blocks = (t[:, :, blk_idx] + pe).reshape(B, G_KV, Nc, CMP_LEN * ATT_HD)
        return jax.nn.silu(blocks @ w1) @ w2

    kc = compress(k_c, pe_ck, w_ck1, w_ck2)
    vc = compress(v_c, pe_cv, w_cv1, w_cv2)
    centre = starts + (CMP_LEN - 1) / 2.0
    ends = starts + CMP_LEN - 1
    s_c = jnp.einsum('bghtd,bgnd->bghtn', qh, kc) - slopes * (pos[:, None] - centre[None, :])
    p_c = masked_softmax(s_c, ends[None, :] <= pos[:, None])
    o_cmp = jnp.einsum('bghtn,bgnd->bghtd', p_c.astype(vc.dtype), vc)

    Ns = T // SLC_LEN
    s_start = SLC_LEN * jnp.arange(Ns)
    overlap = ((starts[:, None] + CMP_LEN > s_start[None, :]) &
               (starts[:, None] < s_start[None, :] + SLC_LEN)).astype(jnp.float32)
    imp = jnp.einsum('bgtn,ns->bgts', jnp.sum(p_c, axis=2), overlap)
    cur = pos // SLC_LEN
    jb = jnp.arange(Ns)
    valid = s_start[None, :] <= pos[:, None]
    forced = (jb[None, :] == 0) | (jb[None, :] == cur[:, None]) | (jb[None, :] == cur[:, None] - 1)
    score = jnp.where(valid, imp + jnp.where(forced, FORCE_BONUS, 0.0), -jnp.inf)
    _, sel = lax.top_k(score, n_sel)

    nQ = T // Q_BLOCK
    q_blocks = qh.reshape(B, G_KV, HG, nQ, Q_BLOCK, ATT_HD).transpose(3, 0, 1, 2, 4, 5)
    blk_ids = jnp.arange(nQ)

    Kb = k_s.reshape(B, G_KV, Ns, SLC_LEN, ATT_HD)
    Vb = v_s.reshape(B, G_KV, Ns, SLC_LEN, ATT_HD)
    sel_blocks = sel.reshape(B, G_KV, nQ, Q_BLOCK, n_sel).transpose(2, 0, 1, 3, 4)
    bi = jnp.arange(B)[:, None, None, None]
    gi = jnp.arange(G_KV)[None, :, None, None]
    n_keys = n_sel * SLC_LEN

    def sel_attend(args):
        qb, ib, c = args
        kg = Kb[bi, gi, ib].reshape(B, G_KV, Q_BLOCK, n_keys, ATT_HD)
        vg = Vb[bi, gi, ib].reshape(B, G_KV, Q_BLOCK, n_keys, ATT_HD)
        k_pos = (ib[..., None] * SLC_LEN + jnp.arange(SLC_LEN)).reshape(B, G_KV, Q_BLOCK, n_keys)
        t_q = c * Q_BLOCK + jnp.arange(Q_BLOCK)
        dist = (t_q[None, None, :, None] - k_pos)[:, :, None]
        s = jnp.einsum('bghqd,bgqkd->bghqk', qb, kg) - slopes * dist
        p = masked_softmax(s, dist >= 0)
        return jnp.einsum('bghqk,bgqkd->bghqd', p.astype(vg.dtype), vg)

    o_slc = lax.map(sel_attend, (q_blocks, sel_blocks, blk_ids))

    KW = WINDOW + Q_BLOCK
    kw_pad = jnp.pad(k_w, ((0, 0), (0, 0), (WINDOW, 0), (0, 0)))
    vw_pad = jnp.pad(v_w, ((0, 0), (0, 0), (WINDOW, 0), (0, 0)))

    def win_attend(args):
        qb, c = args
        kb = lax.dynamic_slice_in_dim(kw_pad, c * Q_BLOCK, KW, axis=2)
        vb = lax.dynamic_slice_in_dim(vw_pad, c * Q_BLOCK, KW, axis=2)
        t_q = c * Q_BLOCK + jnp.arange(Q_BLOCK)
        k_pos = c * Q_BLOCK - WINDOW + jnp.arange(KW)
        dist = t_q[:, None] - k_pos[None, :]
        mask = (dist >= 0) & (dist < WINDOW) & (k_pos[None, :] >= 0)
        s = jnp.einsum('bghqd,bgkd->bghqk', qb, kb) - slopes * dist
        p = masked_softmax(s, mask)
        return jnp.einsum('bghqk,bgkd->bghqd', p.astype(vb.dtype), vb)

    o_win = lax.map(win_attend, (q_blocks, blk_ids))

    def unblock(o):
        return o.transpose(1, 2, 3, 0, 4, 5).reshape(B, G_KV, HG, T, ATT_HD)

    g = jax.nn.sigmoid(gate_logits.astype(jnp.float32)).reshape(B, T, G_KV, HG, 3)
    g = g.transpose(0, 2, 3, 1, 4).astype(q.dtype)
    o = (g[..., 0:1] * o_cmp + g[..., 1:2] * unblock(o_slc) + g[..., 2:3] * unblock(o_win))
    return o.transpose(0, 3, 1, 2, 4).reshape(B, T, ATT_WIDTH)


def cross_attention(a, memn, w_xq, w_xkv, w_xo):
    B, T, _ = a.shape
    M = memn.shape[1]
    q = (a @ w_xq).reshape(B, T, H_X, X_HD) * (X_HD ** -0.5)
    k, v = jnp.split(memn @ w_xkv, 2, axis=-1)
    k = k.reshape(B, M, H_X, X_HD)
    v = v.reshape(B, M, H_X, X_HD)
    p = jax.nn.softmax(jnp.einsum('bthd,bmhd->bhtm', q, k).astype(jnp.float32), axis=-1)
    o = jnp.einsum('bhtm,bmhd->bthd', p.astype(v.dtype), v).reshape(B, T, H_X * X_HD)
    return o @ w_xo


def setup_inputs(seed: int = 0) -> dict:
    key = jax.random.key(seed)
    ks = jax.random.split(key, 24)
    L = DEPTH
    f32 = jnp.float32

    def w(k, shape, fan_in):
        return jax.random.normal(k, shape, f32) * fan_in ** -0.5

    def gain(k, shape):
        return 1.0 + 0.02 * jax.random.normal(k, shape, f32)

    flat = CMP_LEN * ATT_HD
    return {
        "x": jax.random.normal(ks[0], (BATCH, SEQ, D_MODEL), f32),
        "mem": jax.random.normal(ks[1], (BATCH, N_MEM, D_MODEL), f32),
        "g_mix": gain(ks[2], (L, D_MODEL)),
        "w_in": w(ks[3], (L, D_MODEL, IN_WIDTH), D_MODEL),
        "lower_bounds": 0.1 * jax.random.normal(ks[4], (L + 1, RNN_WIDTH), f32),
        "g_rnn_out": gain(ks[5], (L, RNN_VDIM)),
        "pe_ck": 0.1 * jax.random.normal(ks[6], (L, CMP_LEN, ATT_HD), f32),
        "w_ck1": w(ks[7], (L, flat, CMP_HIDDEN), flat),
        "w_ck2": w(ks[8], (L, CMP_HIDDEN, ATT_HD), CMP_HIDDEN),
        "pe_cv": 0.1 * jax.random.normal(ks[9], (L, CMP_LEN, ATT_HD), f32),
        "w_cv1": w(ks[10], (L, flat, CMP_HIDDEN), flat),
        "w_cv2": w(ks[11], (L, CMP_HIDDEN, ATT_HD), CMP_HIDDEN),
        "w_proj_rnn": w(ks[12], (L, RNN_VWIDTH, D_MODEL), RNN_VWIDTH),
        "w_proj_att": w(ks[13], (L, ATT_WIDTH, D_MODEL), ATT_WIDTH),
        "w_out": w(ks[14], (L, D_MODEL, D_MODEL), D_MODEL),
        "g_xattn": gain(ks[15], (L, D_MODEL)),
        "g_mem": gain(ks[16], (L, D_MODEL)),
        "w_xq": w(ks[17], (L, D_MODEL, H_X * X_HD), D_MODEL),
        "w_xkv": w(ks[18], (L, D_MODEL, 2 * H_X * X_HD), D_MODEL),
        "w_xo": w(ks[19], (L, H_X * X_HD, D_MODEL), H_X * X_HD),
        "g_ffn": gain(ks[20], (L, D_MODEL)),
        "w_gate_up": w(ks[21], (L, D_MODEL, 2 * D_FF), D_MODEL),
        "w_down": w(ks[22], (L, D_FF, D_MODEL), D_FF),
        "g_final": gain(ks[23], (D_MODEL,)),
    }


def reference(x, mem, g_mix, w_in, lower_bounds, g_rnn_out, pe_ck, w_ck1, w_ck2,
              pe_cv, w_cv1, w_cv2, w_proj_rnn, w_proj_att, w_out, g_xattn, g_mem,
              w_xq, w_xkv, w_xo, g_ffn, w_gate_up, w_down, g_final):
    split_points = np.cumsum(SPLIT_SIZES)[:-1].tolist()
    lbs = jnp.cumsum(jax.nn.softmax(lower_bounds.astype(jnp.float32), axis=0), axis=0)
    h = x
    for l in range(DEPTH):
        a = rms_norm(h, g_mix[l])
        q_r, f_r, i_r, og_r, q_a, kv_a, gate_a, mg_r, mg_a = jnp.split(a @ w_in[l], split_points, axis=-1)
        y_r = hgrn2(q_r, f_r, i_r, og_r, lbs[l], g_rnn_out[l])
        y_a = nsa(q_a, kv_a, gate_a, pe_ck[l], w_ck1[l], w_ck2[l], pe_cv[l], w_cv1[l], w_cv2[l])
        merged = (jax.nn.sigmoid(mg_r) * (y_r @ w_proj_rnn[l]) +
                  jax.nn.sigmoid(mg_a) * (y_a @ w_proj_att[l]))
        h = h + merged @ w_out[l]
        h = h + cross_attention(rms_norm(h, g_xattn[l]), rms_norm(mem, g_mem[l]),
                                w_xq[l], w_xkv[l], w_xo[l])
        gt, up = jnp.split(rms_norm(h, g_ffn[l]) @ w_gate_up[l], 2, axis=-1)
        h = h + (jax.nn.silu(gt) * up) @ w_down[l]
    return rms_norm(h, g_final)
```

```cpp
#include <hip/hip_runtime.h>
#include <math.h>

namespace gold {
constexpr int D_MODEL = 1024, BATCH = 8, SEQ = 2048, N_MEM = 256;
constexpr int IN_W = 8752;
constexpr int O_QR = 0, O_FR = 1024, O_IR = 2048, O_OG = 3072, O_QA = 4096, O_KV = 5120, O_GATE = 6656, O_MGR = 6704, O_MGA = 7728;
constexpr int D_FF = 2816;
constexpr int NC = 127;

__device__ __forceinline__ float wave_sum(float v) {
#pragma unroll
    for (int o = 1; o < 64; o <<= 1) v += __shfl_xor(v, o);
    return v;
}
__device__ __forceinline__ float wave_max(float v) {
#pragma unroll
    for (int o = 1; o < 64; o <<= 1) v = fmaxf(v, __shfl_xor(v, o));
    return v;
}
__device__ __forceinline__ float sigmoidf_(float x) { return 1.0f / (1.0f + expf(-x)); }
__device__ __forceinline__ float siluf_(float x) { return x / (1.0f + expf(-x)); }

__global__ __launch_bounds__(256) void g_rmsnorm(const float* __restrict__ x, const float* __restrict__ g, float* __restrict__ y) {
    __shared__ float red[4];
    const int row = blockIdx.x, tid = threadIdx.x;
    const float4 v = *(const float4*)(x + (size_t)row * 1024 + tid * 4);
    float s = v.x * v.x + v.y * v.y + v.z * v.z + v.w * v.w;
    s = wave_sum(s);
    if ((tid & 63) == 0) red[tid >> 6] = s;
    __syncthreads();
    const float tot = red[0] + red[1] + red[2] + red[3];
    const float r = rsqrtf(tot * (1.0f / 1024.0f) + 1e-6f);
    const float4 gg = *(const float4*)(g + tid * 4);
    float4 o; o.x = v.x * r * gg.x; o.y = v.y * r * gg.y; o.z = v.z * r * gg.z; o.w = v.w * r * gg.w;
    *(float4*)(y + (size_t)row * 1024 + tid * 4) = o;
}

__global__ __launch_bounds__(256) void g_gemm(const float* __restrict__ A, int lda, const float* __restrict__ B, int ldb, float* __restrict__ C, int ldc, int M, int N, int K) {
    __shared__ float As[16][68];
    __shared__ float Bs[16][68];
    const int tid = threadIdx.x, tx = tid & 15, ty = tid >> 4;
    const int m0 = blockIdx.y * 64, n0 = blockIdx.x * 64;
    float acc[4][4];
#pragma unroll
    for (int i = 0; i < 4; ++i)
#pragma unroll
        for (int j = 0; j < 4; ++j) acc[i][j] = 0.f;
    for (int k0 = 0; k0 < K; k0 += 16) {
        {
            const int r = tid >> 2, kq = (tid & 3) * 4, gm = m0 + r;
            float4 v = make_float4(0.f, 0.f, 0.f, 0.f);
            if (gm < M) v = *(const float4*)(A + (size_t)gm * lda + k0 + kq);
            As[kq][r] = v.x; As[kq + 1][r] = v.y; As[kq + 2][r] = v.z; As[kq + 3][r] = v.w;
        }
        {
            const int kk = tid >> 4, nq = (tid & 15) * 4, gn = n0 + nq;
            float4 v = make_float4(0.f, 0.f, 0.f, 0.f);
            if (gn < N) v = *(const float4*)(B + (size_t)(k0 + kk) * ldb + gn);
            Bs[kk][nq] = v.x; Bs[kk][nq + 1] = v.y; Bs[kk][nq + 2] = v.z; Bs[kk][nq + 3] = v.w;
        }
        __syncthreads();
#pragma unroll
        for (int kk = 0; kk < 16; ++kk) {
            const float4 a = *(const float4*)&As[kk][ty * 4];
            const float4 b = *(const float4*)&Bs[kk][tx * 4];
            acc[0][0] += a.x * b.x; acc[0][1] += a.x * b.y; acc[0][2] += a.x * b.z; acc[0][3] += a.x * b.w;
            acc[1][0] += a.y * b.x; acc[1][1] += a.y * b.y; acc[1][2] += a.y * b.z; acc[1][3] += a.y * b.w;
            acc[2][0] += a.z * b.x; acc[2][1] += a.z * b.y; acc[2][2] += a.z * b.z; acc[2][3] += a.z * b.w;
            acc[3][0] += a.w * b.x; acc[3][1] += a.w * b.y; acc[3][2] += a.w * b.z; acc[3][3] += a.w * b.w;
        }
        __syncthreads();
    }
#pragma unroll
    for (int i = 0; i < 4; ++i) {
        const int gm = m0 + ty * 4 + i, gn = n0 + tx * 4;
        if (gm < M && gn < N) *(float4*)(C + (size_t)gm * ldc + gn) = make_float4(acc[i][0], acc[i][1], acc[i][2], acc[i][3]);
    }
}

__global__ __launch_bounds__(256) void g_hgrn(const float* __restrict__ proj, const float* __restrict__ lb_raw, float* __restrict__ o_raw) {
    __shared__ float red[8][32];
    const int vs = blockIdx.x, h = blockIdx.y, tid = threadIdx.x, v = tid & 31, kg = tid >> 5;
    float S[16], lb[16];
#pragma unroll
    for (int j = 0; j < 16; ++j) {
        S[j] = 0.f;
        const int c = h * 128 + kg * 16 + j;
        lb[j] = 1.0f / (1.0f + expf(lb_raw[1024 + c] - lb_raw[c]));
    }
    for (int t = 0; t < SEQ; ++t) {
        const float* prow = proj + (size_t)t * IN_W;
        const float iv = prow[O_IR + h * 128 + vs * 32 + v];
        float part = 0.f;
#pragma unroll
        for (int j4 = 0; j4 < 4; ++j4) {
            const float4 q4 = *(const float4*)(prow + O_QR + h * 128 + kg * 16 + j4 * 4);
            const float4 f4 = *(const float4*)(prow + O_FR + h * 128 + kg * 16 + j4 * 4);
            const float qq[4] = {q4.x, q4.y, q4.z, q4.w};
            const float ff[4] = {f4.x, f4.y, f4.z, f4.w};
#pragma unroll
            for (int e = 0; e < 4; ++e) {
                const int j = j4 * 4 + e;
                const float f = lb[j] + (1.0f - lb[j]) * sigmoidf_(ff[e]);
                S[j] = f * S[j] + (1.0f - f) * iv;
                part += S[j] * siluf_(qq[e]);
            }
        }
        red[kg][v] = part;
        __syncthreads();
        if (kg == 0) {
            float o = 0.f;
#pragma unroll
            for (int i = 0; i < 8; ++i) o += red[i][v];
            o_raw[(size_t)t * 1024 + h * 128 + vs * 32 + v] = o;
        }
        __syncthreads();
    }
}

__global__ __launch_bounds__(128) void g_hgrn_out(const float* __restrict__ o_raw, const float* __restrict__ proj, const float* __restrict__ g_norm, float* __restrict__ y_r) {
    __shared__ float red[2];
    const int h = blockIdx.x, t = blockIdx.y, v = threadIdx.x;
    const float o = o_raw[(size_t)t * 1024 + h * 128 + v];
    float s = wave_sum(o * o);
    if ((v & 63) == 0) red[v >> 6] = s;
    __syncthreads();
    const float r = rsqrtf((red[0] + red[1]) * (1.0f / 128.0f) + 1e-6f);
    const float og = proj[(size_t)t * IN_W + O_OG + h * 128 + v];
    y_r[(size_t)t * 1024 + h * 128 + v] = o * r * g_norm[v] * siluf_(og);
}

__global__ __launch_bounds__(128) void g_compress(const float* __restrict__ proj, int col0, const float* __restrict__ pe, const float* __restrict__ w1, const float* __restrict__ w2, float* __restrict__ out) {
    __shared__ float xs[2048];
    __shared__ float hs[128];
    const int n = blockIdx.x, g = blockIdx.y, tid = threadIdx.x;
    for (int i = tid; i < 2048; i += 128) {
        const int l = i >> 6, d = i & 63;
        xs[i] = proj[(size_t)(16 * n + l) * IN_W + col0 + g * 64 + d] + pe[i];
    }
    __syncthreads();
    float a = 0.f;
    for (int i = 0; i < 2048; ++i) a += xs[i] * w1[(size_t)i * 128 + tid];
    hs[tid] = siluf_(a);
    __syncthreads();
    if (tid < 64) {
        float o = 0.f;
        for (int j = 0; j < 128; ++j) o += hs[j] * w2[j * 64 + tid];
        out[((size_t)g * NC + n) * 64 + tid] = o;
    }
}

__device__ __forceinline__ float dot64(const float* __restrict__ qs, const float* __restrict__ kr) {
    float d = 0.f;
#pragma unroll
    for (int k4 = 0; k4 < 16; ++k4) {
        const float4 kv = *(const float4*)(kr + k4 * 4);
        d += qs[k4 * 4] * kv.x + qs[k4 * 4 + 1] * kv.y + qs[k4 * 4 + 2] * kv.z + qs[k4 * 4 + 3] * kv.w;
    }
    return d;
}

__global__ __launch_bounds__(256) void g_nsa(const float* __restrict__ proj, const float* __restrict__ kc, const float* __restrict__ vc, float* __restrict__ y_a) {
    __shared__ float q_s[4][64];
    __shared__ float p_s[4][512];
    __shared__ float pc_s[4][128];
    __shared__ float imp_s[32];
    __shared__ int sel_s[8];
    __shared__ int nsel_s;
    const int t = blockIdx.x, g = blockIdx.y;
    const int w = threadIdx.x >> 6, lane = threadIdx.x & 63;
    const int h = g * 4 + w;
    const float slope = exp2f(-8.0f * (float)(h + 1) / 16.0f);
    const float* prow = proj + (size_t)t * IN_W;
    q_s[w][lane] = prow[O_QA + h * 64 + lane] * 0.125f;
    __syncthreads();
    float s0 = -INFINITY, s1 = -INFINITY;
    {
        const int n0 = lane, n1 = lane + 64;
        if (16 * n0 + 31 <= t) s0 = dot64(q_s[w], kc + ((size_t)g * NC + n0) * 64) - slope * ((float)t - (16.0f * n0 + 15.5f));
        if (n1 < NC && 16 * n1 + 31 <= t) s1 = dot64(q_s[w], kc + ((size_t)g * NC + n1) * 64) - slope * ((float)t - (16.0f * n1 + 15.5f));
    }
    float m = wave_max(fmaxf(s0, s1));
    if (!(m > -INFINITY)) m = 0.f;
    float p0 = expf(s0 - m), p1 = expf(s1 - m);
    float dsum = wave_sum(p0 + p1);
    if (!(dsum > 0.f)) dsum = 1.f;
    p0 /= dsum; p1 /= dsum;
    pc_s[w][lane] = p0; pc_s[w][lane + 64] = p1;
    __syncthreads();
    float o_cmp = 0.f;
    for (int n = 0; n < NC; ++n) o_cmp += pc_s[w][n] * vc[((size_t)g * NC + n) * 64 + lane];
    if (threadIdx.x < 32) {
        const int s = threadIdx.x;
        float im = 0.f;
        for (int n = 4 * s - 1; n <= 4 * s + 3; ++n)
            if (n >= 0 && n < NC) im += ((pc_s[0][n] + pc_s[1][n]) + pc_s[2][n]) + pc_s[3][n];
        imp_s[s] = im;
    }
    __syncthreads();
    if (threadIdx.x == 0) {
        const int cur = t >> 6;
        unsigned used = 0u; int cnt = 0;
        for (int i = 0; i < 8; ++i) {
            float best = -INFINITY; int bi = -1;
            for (int s = 0; s < 32; ++s) {
                if ((used >> s) & 1u) continue;
                if (64 * s > t) continue;
                const float sc = imp_s[s] + ((s == 0 || s == cur || s == cur - 1) ? 1.0e4f : 0.0f);
                if (sc > best) { best = sc; bi = s; }
            }
            if (bi < 0) break;
            used |= 1u << bi; sel_s[cnt++] = bi;
        }
        nsel_s = cnt;
    }
    __syncthreads();
    float o_slc = 0.f;
    {
        const int ns = nsel_s;
        float mx = -INFINITY;
        for (int i = 0; i < ns; ++i) {
            const int kp = 64 * sel_s[i] + lane;
            float sc = -INFINITY;
            if (kp <= t) sc = dot64(q_s[w], proj + (size_t)kp * IN_W + O_KV + 512 + g * 64) - slope * (float)(t - kp);
            p_s[w][i * 64 + lane] = sc;
            mx = fmaxf(mx, sc);
        }
        mx = wave_max(mx);
        float sum = 0.f;
        for (int i = 0; i < ns; ++i) { const float e = expf(p_s[w][i * 64 + lane] - mx); p_s[w][i * 64 + lane] = e; sum += e; }
        sum = wave_sum(sum);
        __syncthreads();
        for (int i = 0; i < ns; ++i) {
            const float* vb = proj + (size_t)(64 * sel_s[i]) * IN_W + O_KV + 768 + g * 64 + lane;
            for (int kk = 0; kk < 64; ++kk) o_slc += p_s[w][i * 64 + kk] * vb[(size_t)kk * IN_W];
        }
        o_slc /= sum;
    }
    __syncthreads();
    float o_win = 0.f;
    {
        float mx = -INFINITY;
        for (int i = 0; i < 8; ++i) {
            const int kp = t - 511 + i * 64 + lane;
            float sc = -INFINITY;
            if (kp >= 0) sc = dot64(q_s[w], proj + (size_t)kp * IN_W + O_KV + 1024 + g * 64) - slope * (float)(t - kp);
            p_s[w][i * 64 + lane] = sc;
            mx = fmaxf(mx, sc);
        }
        mx = wave_max(mx);
        float sum = 0.f;
        for (int i = 0; i < 8; ++i) { const float e = expf(p_s[w][i * 64 + lane] - mx); p_s[w][i * 64 + lane] = e; sum += e; }
        sum = wave_sum(sum);
        __syncthreads();
        for (int i = 0; i < 512; ++i) {
            const int kp = t - 511 + i;
            if (kp >= 0) o_win += p_s[w][i] * proj[(size_t)kp * IN_W + O_KV + 1280 + g * 64 + lane];
        }
        o_win /= sum;
    }
    const float g0 = sigmoidf_(prow[O_GATE + h * 3 + 0]), g1 = sigmoidf_(prow[O_GATE + h * 3 + 1]), g2 = sigmoidf_(prow[O_GATE + h * 3 + 2]);
    y_a[(size_t)t * 1024 + h * 64 + lane] = g0 * o_cmp + g1 * o_slc + g2 * o_win;
}

__global__ __launch_bounds__(256) void g_merge(const float* __restrict__ proj, const float* __restrict__ pr, const float* __restrict__ pa, float* __restrict__ merged) {
    const int t = blockIdx.x;
    for (int c = threadIdx.x; c < 1024; c += 256) {
        const float gr = sigmoidf_(proj[(size_t)t * IN_W + O_MGR + c]), ga = sigmoidf_(proj[(size_t)t * IN_W + O_MGA + c]);
        merged[(size_t)t * 1024 + c] = gr * pr[(size_t)t * 1024 + c] + ga * pa[(size_t)t * 1024 + c];
    }
}
__global__ __launch_bounds__(256) void g_add(const float* __restrict__ a, const float* __restrict__ b, float* __restrict__ o, int n4) {
    const int i = blockIdx.x * 256 + threadIdx.x;
    if (i < n4) { const float4 x = ((const float4*)a)[i], y = ((const float4*)b)[i]; ((float4*)o)[i] = make_float4(x.x + y.x, x.y + y.y, x.z + y.z, x.w + y.w); }
}
__global__ __launch_bounds__(256) void g_swiglu(const float* __restrict__ gu, float* __restrict__ act) {
    const int t = blockIdx.x;
    for (int c = threadIdx.x; c < D_FF; c += 256) {
        const float gt = gu[(size_t)t * (2 * D_FF) + c], up = gu[(size_t)t * (2 * D_FF) + D_FF + c];
        act[(size_t)t * D_FF + c] = siluf_(gt) * up;
    }
}
__global__ __launch_bounds__(256) void k_xattn(const float* __restrict__ q, const float* __restrict__ kvm, float* __restrict__ o) {
    __shared__ float q_s[128];
    __shared__ float p_s[256];
    __shared__ float red[4];
    const int t = blockIdx.x, h = blockIdx.y, tid = threadIdx.x;
    if (tid < 128) q_s[tid] = q[(size_t)t * 512 + h * 128 + tid] * 0.08838834764831845f;
    __syncthreads();
    const float* kr = kvm + (size_t)tid * 1024 + h * 128;
    float s = 0.f;
    for (int k4 = 0; k4 < 32; ++k4) { const float4 kv = *(const float4*)(kr + k4 * 4); s += q_s[k4 * 4] * kv.x + q_s[k4 * 4 + 1] * kv.y + q_s[k4 * 4 + 2] * kv.z + q_s[k4 * 4 + 3] * kv.w; }
    float m = wave_max(s);
    if ((tid & 63) == 0) red[tid >> 6] = m;
    __syncthreads();
    m = fmaxf(fmaxf(red[0], red[1]), fmaxf(red[2], red[3]));
    __syncthreads();
    const float e = expf(s - m);
    p_s[tid] = e;
    float sum = wave_sum(e);
    if ((tid & 63) == 0) red[tid >> 6] = sum;
    __syncthreads();
    sum = red[0] + red[1] + red[2] + red[3];
    if (tid < 128) {
        float acc = 0.f;
        for (int mm = 0; mm < 256; ++mm) acc += p_s[mm] * kvm[(size_t)mm * 1024 + 512 + h * 128 + tid];
        o[(size_t)t * 512 + h * 128 + tid] = acc / sum;
    }
}

inline void gemm(hipStream_t st, const float* A, int lda, const float* B, int ldb, float* C, int ldc, int M, int N, int K) {
    dim3 grid((N + 63) / 64, (M + 63) / 64);
    hipLaunchKernelGGL(g_gemm, grid, dim3(256), 0, st, A, lda, B, ldb, C, ldc, M, N, K);
}

inline void forward(void* const* d_in, float* out, float* ws, hipStream_t st) {
    const float* x = (const float*)d_in[0]; const float* mem = (const float*)d_in[1]; const float* g_mix = (const float*)d_in[2];
    const float* w_in = (const float*)d_in[3]; const float* lower_bounds = (const float*)d_in[4]; const float* g_rnn_out = (const float*)d_in[5];
    const float* pe_ck = (const float*)d_in[6]; const float* w_ck1 = (const float*)d_in[7]; const float* w_ck2 = (const float*)d_in[8];
    const float* pe_cv = (const float*)d_in[9]; const float* w_cv1 = (const float*)d_in[10]; const float* w_cv2 = (const float*)d_in[11];
    const float* w_proj_rnn = (const float*)d_in[12]; const float* w_proj_att = (const float*)d_in[13]; const float* w_out = (const float*)d_in[14];
    const float* g_xattn = (const float*)d_in[15]; const float* g_mem = (const float*)d_in[16]; const float* w_xq = (const float*)d_in[17];
    const float* w_xkv = (const float*)d_in[18]; const float* w_xo = (const float*)d_in[19]; const float* g_ffn = (const float*)d_in[20];
    const float* w_gate_up = (const float*)d_in[21]; const float* w_down = (const float*)d_in[22]; const float* g_final = (const float*)d_in[23];
    const size_t TD = (size_t)SEQ * 1024;
    float* p = ws;
    float* AN = p; p += TD;
    float* PROJ = p; p += (size_t)SEQ * IN_W;
    float* GU = PROJ;
    float* ORAW = p; p += TD; float* YR = p; p += TD; float* YA = p; p += TD; float* PR = p; p += TD; float* PA = p; p += TD;
    float* MERGED = p; p += TD; float* H1 = p; p += TD; float* QX = p; p += TD; float* OX = p; p += TD; float* H2 = p; p += TD; float* H3 = p; p += TD;
    float* TMP = p; p += TD;
    float* ACT = p; p += (size_t)SEQ * D_FF;
    float* KC = p; p += 4 * NC * 64; float* VC = p; p += 4 * NC * 64;
    float* MEMN = p; p += (size_t)N_MEM * 1024; float* KVM = p; p += (size_t)N_MEM * 2048;
    for (int b = 0; b < BATCH; ++b) {
        const float* xb = x + (size_t)b * TD;
        hipLaunchKernelGGL(g_rmsnorm, dim3(SEQ), dim3(256), 0, st, xb, g_mix, AN);
        gemm(st, AN, 1024, w_in, IN_W, PROJ, IN_W, SEQ, IN_W, 1024);
        hipLaunchKernelGGL(g_hgrn, dim3(4, 8), dim3(256), 0, st, PROJ, lower_bounds, ORAW);
        hipLaunchKernelGGL(g_hgrn_out, dim3(8, SEQ), dim3(128), 0, st, ORAW, PROJ, g_rnn_out, YR);
        hipLaunchKernelGGL(g_compress, dim3(NC, 4), dim3(128), 0, st, PROJ, O_KV + 0, pe_ck, w_ck1, w_ck2, KC);
        hipLaunchKernelGGL(g_compress, dim3(NC, 4), dim3(128), 0, st, PROJ, O_KV + 256, pe_cv, w_cv1, w_cv2, VC);
        hipLaunchKernelGGL(g_nsa, dim3(SEQ, 4), dim3(256), 0, st, PROJ, KC, VC, YA);
        gemm(st, YR, 1024, w_proj_rnn, 1024, PR, 1024, SEQ, 1024, 1024);
        gemm(st, YA, 1024, w_proj_att, 1024, PA, 1024, SEQ, 1024, 1024);
        hipLaunchKernelGGL(g_merge, dim3(SEQ), dim3(256), 0, st, PROJ, PR, PA, MERGED);
        gemm(st, MERGED, 1024, w_out, 1024, TMP, 1024, SEQ, 1024, 1024);
        hipLaunchKernelGGL(g_add, dim3(TD / 4 / 256), dim3(256), 0, st, xb, TMP, H1, (int)(TD / 4));
        hipLaunchKernelGGL(g_rmsnorm, dim3(SEQ), dim3(256), 0, st, H1, g_xattn, AN);
        hipLaunchKernelGGL(g_rmsnorm, dim3(N_MEM), dim3(256), 0, st, mem + (size_t)b * N_MEM * 1024, g_mem, MEMN);
        gemm(st, AN, 1024, w_xq, 512, QX, 512, SEQ, 512, 1024);
        gemm(st, MEMN, 1024, w_xkv, 1024, KVM, 1024, N_MEM, 1024, 1024);
        hipLaunchKernelGGL(k_xattn, dim3(SEQ, 4), dim3(256), 0, st, QX, KVM, OX);
        gemm(st, OX, 512, w_xo, 1024, TMP, 1024, SEQ, 1024, 512);
        hipLaunchKernelGGL(g_add, dim3(TD / 4 / 256), dim3(256), 0, st, H1, TMP, H2, (int)(TD / 4));
        hipLaunchKernelGGL(g_rmsnorm, dim3(SEQ), dim3(256), 0, st, H2, g_ffn, AN);
        gemm(st, AN, 1024, w_gate_up, 2 * D_FF, GU, 2 * D_FF, SEQ, 2 * D_FF, 1024);
        hipLaunchKernelGGL(g_swiglu, dim3(SEQ), dim3(256), 0, st, GU, ACT);
        gemm(st, ACT, D_FF, w_down, 1024, TMP, 1024, SEQ, 1024, D_FF);
        hipLaunchKernelGGL(g_add, dim3(TD / 4 / 256), dim3(256), 0, st, H2, TMP, H3, (int)(TD / 4));
        hipLaunchKernelGGL(g_rmsnorm, dim3(SEQ), dim3(256), 0, st, H3, g_final, out + (size_t)b * TD);
    }
}
}

extern "C" void kernel_launch(void* const* d_in, const int* in_sizes, int n_in, void* d_out, int out_size, void* d_ws, size_t ws_size, hipStream_t stream) {
    gold::forward(d_in, (float*)d_out, (float*)d_ws, stream);
}
```

```cpp
#include <hip/hip_runtime.h>
#include <cstdio>
#include <cstdint>
namespace pg8 {
#define PG8_LAS __attribute__((address_space(3)))
typedef unsigned short bf16_t;
typedef short bf16x8 __attribute__((ext_vector_type(8)));
typedef float f32x4 __attribute__((ext_vector_type(4)));
typedef unsigned u32x4 __attribute__((ext_vector_type(4)));
constexpr int BM = 256, BK = 64, HALF = 128, HTB = HALF * BK * 2  , STAGE_BYTES = 8 * HTB, NXCD = 8, WGM = 8;

__host__ __device__ __forceinline__ int lds_byte(int r, int c) { const int st = (r >> 4) * 2 + (c >> 5), rr = r & 15, cc = c & 31, ob = rr * 64 + cc * 2; return st * 1024 + (ob ^ (((ob >> 9) & 1) << 5)); }
__host__ __device__ __forceinline__ void stage_rc(int b, int& R, int& C) { const int st = b / 1024, sb = b % 1024, swz = sb ^ (((sb >> 9) & 1) << 5); R = (st >> 1) * 16 + swz / 64; C = (st & 1) * 32 + (swz % 64) / 2; }
__host__ __device__ __forceinline__ int perm32(int rho) { const int n = rho >> 4, i = rho & 15; return 8 * (i >> 2) + 4 * n + (i & 3); }

struct Unit { int pm, pn; };
struct Gemm { const bf16_t* A; const bf16_t* Bt; int M, N, K; };

struct StaticOrder {
    int nM, nN, nwg, G, c;
    __host__ __device__ void init(int M, int N, int G_, int c_) { nM = M / BM; nN = N / BM; nwg = nM * nN; G = G_; c = c_; }
    __host__ __device__ bool next(int i, Unit& u) const {
        const long L = (long)i * G + c; if (L >= nwg) return false;
        int wgid = (int)L; { const int q = nwg / NXCD, r = nwg % NXCD, xcd = wgid % NXCD, off = wgid / NXCD; wgid = (xcd < r ? xcd * (q + 1) : r * (q + 1) + (xcd - r) * q) + off; }
        const int nig = WGM * nN, gid = wgid / nig, fm = gid * WGM, gsz = (nM - fm) < WGM ? (nM - fm) : WGM;
        u.pm = fm + ((wgid % nig) % gsz); u.pn = (wgid % nig) / gsz; return true;
    }
    __device__ __forceinline__ void a_ready(const Unit&) const {}
    __device__ __forceinline__ void done(const Unit&) const {}
};

__device__ __forceinline__ unsigned cvt_pk_bf16(float lo, float hi) { unsigned r; asm volatile("v_cvt_pk_bf16_f32 %0, %1, %2" : "=v"(r) : "v"(lo), "v"(hi)); return r; }
typedef float f32x2 __attribute__((ext_vector_type(2)));
__device__ __forceinline__ f32x2 gelu_pk(f32x2 v) {
    const f32x2 av = __builtin_elementwise_abs(v), d = av * 0.2316418882f + 1.0f;
    f32x2 t; t.x = __builtin_amdgcn_rcpf(d.x); t.y = __builtin_amdgcn_rcpf(d.y);
    f32x2 q = t * 0.5307027145f + (-0.7265760135f); q = q * t + 0.7107068705f; q = q * t + (-0.142248368f); q = q * t + 0.127414796f; q = q * t;
    const f32x2 s = (v * v) * (-0.72134752044f);
    f32x2 e; e.x = __builtin_amdgcn_exp2f(s.x); e.y = __builtin_amdgcn_exp2f(s.y);
    const f32x2 m = v * (q * e), r = v - m;
    f32x2 o; o.x = v.x < 0.f ? m.x : r.x; o.y = v.y < 0.f ? m.y : r.y; return o;
}

template <int ACT  > struct EpiBf16 {
    static constexpr bool PERM = true, AFTER_DRAIN = false; static_assert(ACT == 0 || ACT == 1, "EpiBf16: ACT is 0 (none) or 1 (gelu_pk)");
    bf16_t* O; int ldc; const float* bias; int split_cols; size_t split_stride; float scale0;
    __device__ __forceinline__ void operator()(const f32x4 (&acc)[2][2][4][2], const Unit& u, int wr, int wc, int fr, int fq) const {
        const int row0 = u.pm * BM + wr * 64 + fr; int colt = u.pn * BM; bf16_t* base = O;
        float sc = 1.f; if (split_cols) { const int t = colt / split_cols; base += (size_t)t * split_stride; colt -= t * split_cols; if (t == 0) sc = scale0; }
        const int col0 = colt + wc * 32 + 8 * fq, bcol0 = u.pn * BM + wc * 32 + 8 * fq;
        f32x4 bv[2][2];
#pragma unroll
        for (int bj = 0; bj < 2; ++bj)
#pragma unroll
            for (int n = 0; n < 2; ++n) bv[bj][n] = bias ? *(const f32x4*)(bias + bcol0 + bj * HALF + 4 * n) : (f32x4){0.f, 0.f, 0.f, 0.f};
#pragma unroll
        for (int ai = 0; ai < 2; ++ai)
#pragma unroll
            for (int m = 0; m < 4; ++m) { bf16_t* rowp = base + (size_t)(row0 + ai * HALF + m * 16) * ldc + col0;
#pragma unroll
                for (int bj = 0; bj < 2; ++bj) { f32x4 v0 = acc[ai][bj][m][0] + bv[bj][0], v1 = acc[ai][bj][m][1] + bv[bj][1];
                    if (ACT == 1) { f32x2 a = gelu_pk((f32x2){v0[0], v0[1]}), b = gelu_pk((f32x2){v0[2], v0[3]}), c = gelu_pk((f32x2){v1[0], v1[1]}), d = gelu_pk((f32x2){v1[2], v1[3]});
                        v0 = (f32x4){a.x, a.y, b.x, b.y}; v1 = (f32x4){c.x, c.y, d.x, d.y}; }
                    v0 = v0 * sc; v1 = v1 * sc; u32x4 w; w.x = cvt_pk_bf16(v0[0], v0[1]); w.y = cvt_pk_bf16(v0[2], v0[3]); w.z = cvt_pk_bf16(v1[0], v1[1]); w.w = cvt_pk_bf16(v1[2], v1[3]);
                    *(u32x4*)(rowp + bj * HALF) = w; } }
    }
};
template <class Epi, class Sched, bool ALIGN_EPI = false, bool SP2 = false>
__device__ __forceinline__ void gemm_phase(PG8_LAS unsigned char* lds, const Gemm g, const Sched& S, const Epi& E) {
    const int tid = threadIdx.x, wid = __builtin_amdgcn_readfirstlane(tid >> 6), lane = tid & 63, wr = wid >> 2, wc = wid & 3, fr = lane & 15, fq = lane >> 4;
    const int K = g.K, nt = K / BK;
    unsigned voffA[2], voffB[2];
#pragma unroll
    for (int i = 0; i < 2; ++i) { int R, C; stage_rc(tid * 16 + i * 8192, R, C); const int Rb = Epi::PERM ? ((R & ~31) + perm32(R & 31)) : R;
        voffA[i] = (unsigned)(R * K + C) * 2u; voffB[i] = (unsigned)(Rb * K + C) * 2u; }
    const size_t kstep = (size_t)(BK * 2);
    const size_t hstep = (size_t)HALF * K * 2;
    const size_t tstep = 2 * hstep;
    const unsigned ldsw = (unsigned)wid * 1024u;
    const int aoff = lds_byte(wr * 64 + fr, fq * 8), boff = lds_byte(wc * 32 + fr, fq * 8);
#define PG8_SA(b, h) (((b) * 2 + (h)) * HTB)
#define PG8_SB(b, h) ((4 + (b) * 2 + (h)) * HTB)
#define PG8_STAGE(bufoff, gbase, voff) do { _Pragma("unroll") for (int _i = 0; _i < 2; ++_i) \
        __builtin_amdgcn_global_load_lds((const unsigned*)((const char*)(gbase) + (voff)[_i]), (PG8_LAS unsigned*)(lds + (bufoff) + ldsw + _i * 8192), 16, 0, 0); } while (0)
#define PG8_LDA(dst, b, h) do { _Pragma("unroll") for (int m = 0; m < 4; ++m) _Pragma("unroll") for (int k = 0; k < 2; ++k) dst[m][k] = *(const PG8_LAS bf16x8*)(lds + PG8_SA(b, h) + aoff + m * 2048 + k * 1024); } while (0)
#define PG8_LDB(dst, b, h) do { _Pragma("unroll") for (int n = 0; n < 2; ++n) _Pragma("unroll") for (int k = 0; k < 2; ++k) dst[n][k] = *(const PG8_LAS bf16x8*)(lds + PG8_SB(b, h) + boff + n * 2048 + k * 1024); } while (0)
#define PG8_MMA(ai, bj, At, Bt) do { __builtin_amdgcn_s_setprio(1); _Pragma("unroll") for (int m = 0; m < 4; ++m) _Pragma("unroll") for (int n = 0; n < 2; ++n) _Pragma("unroll") for (int k = 0; k < 2; ++k) \
        acc[ai][bj][m][n] = __builtin_amdgcn_mfma_f32_16x16x32_bf16(Bt[n][k], At[m][k], acc[ai][bj][m][n], 0, 0, 0); __builtin_amdgcn_s_setprio(0); } while (0)
#define PG8_WAIT_V(n) asm volatile("s_waitcnt vmcnt(" #n ")" ::: "memory")
#define PG8_WAIT_L(n) asm volatile("s_waitcnt lgkmcnt(" #n ")" ::: "memory")
#define PG8_BAR __builtin_amdgcn_s_barrier()
#define PG8_SCHED __builtin_amdgcn_sched_barrier(0)
    Unit cur, nxt; int ui = 0;
    if (!S.next(0, cur)) return;
    f32x4 acc[2][2][4][2];
#pragma unroll
    for (int a = 0; a < 2; ++a)
#pragma unroll
        for (int b = 0; b < 2; ++b)
#pragma unroll
            for (int m = 0; m < 4; ++m)
#pragma unroll
                for (int n = 0; n < 2; ++n) acc[a][b][m][n] = (f32x4){0.f, 0.f, 0.f, 0.f};
    bf16x8 At[4][2], B0[2][2], B1[2][2];
    const char* cA = (const char*)g.A + (size_t)cur.pm * tstep; const char* cB = (const char*)g.Bt + (size_t)cur.pn * tstep;
    S.a_ready(cur);
    if constexpr (SP2) {
        PG8_STAGE(PG8_SB(0, 0), cB, voffB); PG8_STAGE(PG8_SB(0, 1), cB + hstep, voffB); PG8_STAGE(PG8_SA(0, 0), cA, voffA); PG8_STAGE(PG8_SA(0, 1), cA + hstep, voffA);
        if (wr == 1) PG8_BAR;
        PG8_WAIT_V(2); PG8_BAR;
        PG8_STAGE(PG8_SB(1, 0), cB + kstep, voffB); PG8_STAGE(PG8_SA(1, 0), cA + kstep, voffA); PG8_STAGE(PG8_SB(1, 1), cB + hstep + kstep, voffB);
        PG8_WAIT_V(6); PG8_BAR;
    } else {
        PG8_STAGE(PG8_SB(0, 0), cB, voffB); PG8_STAGE(PG8_SA(0, 0), cA, voffA); PG8_STAGE(PG8_SB(0, 1), cB + hstep, voffB); PG8_STAGE(PG8_SA(0, 1), cA + hstep, voffA);
        if (wr == 1) PG8_BAR;
        PG8_WAIT_V(4); PG8_BAR;
        PG8_STAGE(PG8_SB(1, 0), cB + kstep, voffB); PG8_STAGE(PG8_SA(1, 0), cA + kstep, voffA); PG8_STAGE(PG8_SB(1, 1), cB + hstep + kstep, voffB);
        PG8_WAIT_V(6); PG8_BAR;
    }
    for (;;) {
        const bool has_next = S.next(ui + 1, nxt);
        const char* nA = has_next ? (const char*)g.A + (size_t)nxt.pm * tstep : cA; const char* nB = has_next ? (const char*)g.Bt + (size_t)nxt.pn * tstep : cB;
        for (int t = 0; t < nt; t += 2) {
            const bool last = (t == nt - 2);
            const char* a1 = cA + (size_t)(t + 1) * kstep;
            const char* a2 = last ? nA : cA + (size_t)(t + 2) * kstep; const char* b2 = last ? nB : cB + (size_t)(t + 2) * kstep;
            const char* a3 = a2 + kstep; const char* b3 = b2 + kstep;
            if (last && has_next) S.a_ready(nxt);
            if constexpr (SP2) {
            PG8_LDB(B0, 0, 0); PG8_LDB(B1, 0, 1); PG8_SCHED; PG8_LDA(At, 0, 0); PG8_STAGE(PG8_SA(1, 1), a1 + hstep, voffA);
            PG8_WAIT_V(8); PG8_WAIT_L(0); PG8_BAR; PG8_MMA(0, 0, At, B0); PG8_MMA(0, 1, At, B1); PG8_BAR; PG8_SCHED;
            PG8_LDA(At, 0, 1); PG8_STAGE(PG8_SB(0, 0), b2, voffB); PG8_STAGE(PG8_SB(0, 1), b2 + hstep, voffB); PG8_STAGE(PG8_SA(0, 0), a2, voffA);
            PG8_WAIT_V(8); PG8_WAIT_L(0); PG8_BAR; PG8_MMA(1, 0, At, B0); PG8_MMA(1, 1, At, B1); PG8_BAR; PG8_SCHED;
            PG8_LDB(B0, 1, 0); PG8_LDB(B1, 1, 1); PG8_SCHED; PG8_LDA(At, 1, 0); PG8_STAGE(PG8_SA(0, 1), a2 + hstep, voffA);
            PG8_WAIT_V(8); PG8_WAIT_L(0); PG8_BAR; PG8_MMA(0, 0, At, B0); PG8_MMA(0, 1, At, B1); PG8_BAR; PG8_SCHED;
            PG8_LDA(At, 1, 1); PG8_STAGE(PG8_SB(1, 0), b3, voffB); PG8_STAGE(PG8_SB(1, 1), b3 + hstep, voffB); PG8_STAGE(PG8_SA(1, 0), a3, voffA);
            PG8_WAIT_V(8); PG8_WAIT_L(0); PG8_BAR; PG8_MMA(1, 0, At, B0); PG8_MMA(1, 1, At, B1); PG8_BAR; PG8_SCHED;
            } else {
            PG8_LDB(B0, 0, 0); PG8_SCHED; PG8_LDA(At, 0, 0); PG8_STAGE(PG8_SA(1, 1), a1 + hstep, voffA);
            PG8_WAIT_L(8); PG8_BAR; PG8_WAIT_L(0); PG8_MMA(0, 0, At, B0); PG8_BAR; PG8_SCHED;
            PG8_LDB(B1, 0, 1); PG8_STAGE(PG8_SB(0, 0), b2, voffB);
            PG8_BAR; PG8_WAIT_L(0); PG8_MMA(0, 1, At, B1); PG8_BAR;
            PG8_LDA(At, 0, 1); PG8_STAGE(PG8_SA(0, 0), a2, voffA);
            PG8_BAR; PG8_WAIT_L(0); PG8_MMA(1, 0, At, B0); PG8_BAR; PG8_SCHED;
            PG8_STAGE(PG8_SB(0, 1), b2 + hstep, voffB);
            PG8_WAIT_V(6); PG8_BAR; PG8_MMA(1, 1, At, B1); PG8_BAR;
            PG8_LDB(B0, 1, 0); PG8_SCHED; PG8_LDA(At, 1, 0); PG8_STAGE(PG8_SA(0, 1), a2 + hstep, voffA);
            PG8_WAIT_L(8); PG8_BAR; PG8_WAIT_L(0); PG8_MMA(0, 0, At, B0); PG8_BAR; PG8_SCHED;
            PG8_LDB(B1, 1, 1); PG8_STAGE(PG8_SB(1, 0), b3, voffB);
            PG8_BAR; PG8_WAIT_L(0); PG8_MMA(0, 1, At, B1); PG8_BAR;
            PG8_LDA(At, 1, 1); PG8_STAGE(PG8_SA(1, 0), a3, voffA);
            PG8_BAR; PG8_WAIT_L(0); PG8_MMA(1, 0, At, B0); PG8_BAR; PG8_SCHED;
            PG8_STAGE(PG8_SB(1, 1), b3 + hstep, voffB);
            PG8_WAIT_V(6); PG8_BAR; PG8_MMA(1, 1, At, B1); PG8_BAR;
            }
        }
        if constexpr (ALIGN_EPI) { if (wr == 0) PG8_BAR; }
        if constexpr (!Epi::AFTER_DRAIN) { E(acc, cur, wr, wc, fr, fq); S.done(cur); }
        if (!has_next) break;
#pragma unroll
        for (int a = 0; a < 2; ++a)
#pragma unroll
            for (int b = 0; b < 2; ++b)
#pragma unroll
                for (int m = 0; m < 4; ++m)
#pragma unroll
                    for (int n = 0; n < 2; ++n) acc[a][b][m][n] = (f32x4){0.f, 0.f, 0.f, 0.f};
        cur = nxt; cA = nA; cB = nB; ++ui;
        if constexpr (ALIGN_EPI) { if (wr == 1) PG8_BAR; }
    }
    PG8_WAIT_V(0);
    if constexpr (!ALIGN_EPI) { if (wr == 0) PG8_BAR; }
    PG8_BAR;
    if constexpr (Epi::AFTER_DRAIN) { E.fused(acc, cur, wr, wc, fr, fq, lds, wid, lane); S.done(cur); }
#undef PG8_SA
#undef PG8_SB
#undef PG8_STAGE
#undef PG8_LDA
#undef PG8_LDB
#undef PG8_MMA
#undef PG8_WAIT_V
#undef PG8_WAIT_L
#undef PG8_BAR
#undef PG8_SCHED
}
}

#define GAS __attribute__((address_space(1)))
#define LAS __attribute__((address_space(3)))
typedef unsigned short bf16;
typedef unsigned v4u __attribute__((ext_vector_type(4)));
typedef unsigned v2u __attribute__((ext_vector_type(2)));
typedef float f32x4 __attribute__((ext_vector_type(4)));
typedef float f32x16 __attribute__((ext_vector_type(16)));
typedef short bf16x8 __attribute__((ext_vector_type(8)));
typedef short s16x4 __attribute__((ext_vector_type(4)));
typedef _Float16 half_t;

constexpr int NWAVES = 8, NTHREADS = 512;
constexpr int M = 16384, D = 1024, T = 2048, NB = 8, NMEM = 256, DFF = 2816, INW = 8752;
constexpr float EPS = 1e-6f;
constexpr float LOG2E = 1.4426950408889634f;
constexpr float QSCALE = 0.125f * LOG2E;
constexpr float XSCALE = 0.08838834764831845f * LOG2E;

constexpr size_t MiB = 1u << 20;
constexpr size_t WS_CTL = 0, CTL_ZERO_BYTES = 1 * MiB;
constexpr size_t CTL_SS1 = 256 * 1024, CTL_SS2 = 320 * 1024, CTL_SS3 = 384 * 1024;
constexpr int CW_BAR = 4096;
constexpr size_t WS_LB = 1 * MiB;
constexpr size_t WS_WIN = 2 * MiB;
constexpr size_t WS_WPR = 20 * MiB, WS_WPA = 22 * MiB, WS_WOUT = 24 * MiB, WS_WXQ = 26 * MiB, WS_WXKV = 27 * MiB, WS_WXO = 29 * MiB;
constexpr size_t WS_WC1K = 30 * MiB, WS_WC1V = 30 * MiB + 512 * 1024;
constexpr size_t WS_KC = 31 * MiB, WS_VC = 31 * MiB + 512 * 1024;
constexpr size_t WS_KVM = 32 * MiB;
constexpr size_t WS_GATES = 36 * MiB;
constexpr size_t WS_MEMN = 38 * MiB;
constexpr size_t WS_A = 42 * MiB;
constexpr size_t WS_QA = 74 * MiB;
constexpr size_t WS_LOGF = 106 * MiB;
constexpr size_t WS_WGU = 106 * MiB, WS_WDN = 117 * MiB;
constexpr size_t WS_I = 138 * MiB;
constexpr size_t WS_MERGED = 138 * MiB, WS_QX = 138 * MiB, WS_OX = 154 * MiB;
constexpr size_t WS_QATT = 170 * MiB;
constexpr size_t WS_KV = 202 * MiB;
constexpr size_t WS_ACT = 138 * MiB;
constexpr size_t WS_END = 250 * MiB;
static_assert(WS_ACT + (size_t)M * DFF * 2 <= WS_END && WS_WDN + (size_t)1024 * DFF * 2 <= WS_I, "ws map");

constexpr int RING_BYTES = 131072;
constexpr int MISC_OFF = RING_BYTES + 320;
constexpr int LDS_BYTES = 147456;

#define RLX_AGENT __ATOMIC_RELAXED, __HIP_MEMORY_SCOPE_AGENT
__device__ __forceinline__ unsigned f2bf(float f) { unsigned u = __builtin_bit_cast(unsigned, f); return (u + 0x7fffu + ((u >> 16) & 1u)) >> 16; }
__device__ __forceinline__ unsigned pk2(float lo, float hi) { return f2bf(lo) | (f2bf(hi) << 16); }
__device__ __forceinline__ float bf2f(unsigned short b) { return __builtin_bit_cast(float, (unsigned)b << 16); }
__device__ __forceinline__ float bflo(unsigned w) { return __builtin_bit_cast(float, w << 16); }
__device__ __forceinline__ float bfhi(unsigned w) { return __builtin_bit_cast(float, w & 0xffff0000u); }
__device__ __forceinline__ float fast_exp(float x) { return __builtin_amdgcn_exp2f(x * LOG2E); }
__device__ __forceinline__ float fast_rcp(float x) { return __builtin_amdgcn_rcpf(x); }
__device__ __forceinline__ float sigm(float x) { return fast_rcp(1.0f + fast_exp(-x)); }
__device__ __forceinline__ float silu(float x) { return x * sigm(x); }
__device__ __forceinline__ float wave_sum(float v) {
#pragma unroll
    for (int o = 1; o < 64; o <<= 1) v += __shfl_xor(v, o);
    return v;
}
__device__ __forceinline__ float wave_max(float v) {
#pragma unroll
    for (int o = 1; o < 64; o <<= 1) v = fmaxf(v, __shfl_xor(v, o));
    return v;
}
#define XB_TMO      128
#define XB_XCNT(j)  (256  + 64 * (j))
#define XB_XSUB(j)  (1280 + 64 * (j))
#define XB_XGEN(j)  (2304 + 64 * (j))
#define XB_TOP      3328
#define XB_TOPGEN   3392
#define XCD_BAR_WORDS 3456
#define XB_SPIN_CAP (1u << 18)

__device__ __forceinline__ unsigned xb_ld(unsigned* p)              { return __hip_atomic_load(p, __ATOMIC_RELAXED, __HIP_MEMORY_SCOPE_AGENT); }
__device__ __forceinline__ unsigned xb_add(unsigned* p, unsigned v) { return __hip_atomic_fetch_add(p, v, __ATOMIC_RELAXED, __HIP_MEMORY_SCOPE_AGENT); }
__device__ __forceinline__ unsigned xb_xcc_id() { return (unsigned)__builtin_amdgcn_s_getreg((3 << 11) | 20) & 0xFu; }
#define XB_SPIN(cond, bar) do { unsigned _sp = 0; while (cond) { __builtin_amdgcn_s_sleep(1); \
    if ((++_sp & 255u) == 0u) { if (xb_ld(&(bar)[XB_TMO])) break; if (_sp > XB_SPIN_CAP) { atomicAdd(&(bar)[XB_TMO], 1u); break; } } } } while (0)

struct XcdBarrier {
    unsigned* bar; unsigned x;
    volatile LAS unsigned* st;
};

__device__ __forceinline__ XcdBarrier xcd_barrier_post(unsigned* bar, volatile LAS unsigned* st) {
    XcdBarrier b; b.bar = bar; b.x = xb_xcc_id(); b.st = st;
    if (threadIdx.x == 0) (void)xb_add(&bar[XB_XCNT(b.x)], 1u);
    return b;
}
__device__ __forceinline__ void xcd_barrier_complete(unsigned* bar, unsigned x, unsigned& nloc, unsigned& nx) {
    const unsigned G = gridDim.x * gridDim.y * gridDim.z;
    unsigned sum, cnt, mine, sp = 0u;
    for (;;) {
        sum = 0u; cnt = 0u; mine = 0u;
#pragma unroll
        for (unsigned j = 0; j < 16; ++j) { const unsigned c = xb_ld(&bar[XB_XCNT(j)]); sum += c; cnt += (c > 0u) ? 1u : 0u; mine = (j == x) ? c : mine; }
        if (sum == G) break;
        __builtin_amdgcn_s_sleep(1);
        if ((++sp & 255u) == 0u) { if (xb_ld(&bar[XB_TMO])) break; if (sp > XB_SPIN_CAP) { atomicAdd(&bar[XB_TMO], 1u); break; } }
    }
    nloc = mine > 0u ? mine : 1u; nx = cnt > 0u ? cnt : 1u;
}

__device__ __forceinline__ void xcd_barrier(const XcdBarrier& b) {
    asm volatile("s_waitcnt vmcnt(0)" ::: "memory");
    __syncthreads();
    if (threadIdx.x == 0) {
        unsigned* bar = b.bar;
        __builtin_amdgcn_s_waitcnt(0);
        unsigned nloc = b.st[0], nx = b.st[1];
        if (nloc == 0u) { xcd_barrier_complete(bar, b.x, nloc, nx); b.st[0] = nloc; b.st[1] = nx; }
        const unsigned old = xb_add(&bar[XB_XSUB(b.x)], 1u);
        const unsigned gen = old / nloc;
        if (old + 1u == (gen + 1u) * nloc) {
            __builtin_amdgcn_fence(__ATOMIC_RELEASE, "agent");
            asm volatile("s_waitcnt vmcnt(0)" ::: "memory");
            const unsigned og = xb_add(&bar[XB_TOP], 1u);
            const unsigned tg = og / nx;
            if (og + 1u == (tg + 1u) * nx) xb_add(&bar[XB_TOPGEN], 1u);
            else XB_SPIN(xb_ld(&bar[XB_TOPGEN]) == tg, bar);
            __builtin_amdgcn_fence(__ATOMIC_ACQUIRE, "agent");
            xb_add(&bar[XB_XGEN(b.x)], 1u);
            asm volatile("s_waitcnt vmcnt(0)" ::: "memory");
        } else {
            XB_SPIN(xb_ld(&bar[XB_XGEN(b.x)]) == gen, bar);
            __builtin_amdgcn_fence(__ATOMIC_ACQUIRE, "agent");
            asm volatile("s_waitcnt vmcnt(0)" ::: "memory");
        }
    }
    __syncthreads();
}

namespace epi {
using pg8::Unit; using pg8::HALF; using pg8::BM;
typedef pg8::f32x4 f4; typedef pg8::u32x4 u4;
__device__ __forceinline__ u4 pack8(f4 a, f4 b) { u4 w; w.x = pk2(a[0], a[1]); w.y = pk2(a[2], a[3]); w.z = pk2(b[0], b[1]); w.w = pk2(b[2], b[3]); return w; }
__device__ __forceinline__ void unpack8(u4 w, f4& a, f4& b) { a = (f4){bflo(w.x), bfhi(w.x), bflo(w.y), bfhi(w.y)}; b = (f4){bflo(w.z), bfhi(w.z), bflo(w.w), bfhi(w.w)}; }
__device__ __forceinline__ f4 map_sigm(f4 v) { return (f4){sigm(v[0]), sigm(v[1]), sigm(v[2]), sigm(v[3])}; }
__device__ __forceinline__ f4 map_silu(f4 v) { return (f4){silu(v[0]), silu(v[1]), silu(v[2]), silu(v[3])}; }

struct EpiInProj {
    static constexpr bool PERM = true, AFTER_DRAIN = false;
    unsigned char* ws; unsigned char* dout; int tile0;
    __device__ __forceinline__ void operator()(const f4 (&acc)[2][2][4][2], const Unit& u, int wr, int wc, int fr, int fq) const {
        const int ct = tile0 + u.pn;
        int kind, ldc, colt; unsigned short* base;
        if (ct < 4) { kind = 0; base = (unsigned short*)(ws + WS_QA); ldc = 1024; colt = ct * 256; }
        else if (ct < 8) { kind = 1; base = (unsigned short*)(ws + WS_LOGF); ldc = 1024; colt = (ct - 4) * 256; }
        else if (ct < 12) { kind = 2; base = (unsigned short*)(ws + WS_I); ldc = 1024; colt = (ct - 8) * 256; }
        else if (ct < 16) { kind = 3; base = (unsigned short*)(ws + WS_QATT); ldc = 1024; colt = (ct - 12) * 256; }
        else if (ct < 22) { kind = 2; base = (unsigned short*)(ws + WS_KV); ldc = 1536; colt = (ct - 16) * 256; }
        else if (ct < 26) { kind = 4; base = (unsigned short*)(dout); ldc = 1024; colt = (ct - 22) * 256; }
        else if (ct < 30) { kind = 4; base = (unsigned short*)(dout + 32 * MiB); ldc = 1024; colt = (ct - 26) * 256; }
        else if (ct == 30) { kind = 5; base = (unsigned short*)(ws + WS_GATES); ldc = 64; colt = 0; }
        else { kind = 6; base = (unsigned short*)(ws + WS_QA); ldc = 1024; colt = (ct - 31) * 256; }
        const int row0 = u.pm * BM + wr * 64 + fr;
        const int col0 = colt + wc * 32 + 8 * fq;
        f4 lbv[2][2];
        if (kind == 1) {
            const float* lb = (const float*)(ws + WS_LB);
#pragma unroll
            for (int bj = 0; bj < 2; ++bj)
#pragma unroll
                for (int n = 0; n < 2; ++n) lbv[bj][n] = *(const f4*)(lb + col0 + bj * HALF + 4 * n);
        }
        if (kind == 5 && wc >= 2) return;
#pragma unroll
        for (int ai = 0; ai < 2; ++ai)
#pragma unroll
            for (int m = 0; m < 4; ++m) {
                unsigned short* rowp = base + (size_t)(row0 + ai * HALF + m * 16) * ldc + col0;
#pragma unroll
                for (int bj = 0; bj < 2; ++bj) {
                    if (kind == 5 && bj == 1) continue;
                    f4 v0 = acc[ai][bj][m][0], v1 = acc[ai][bj][m][1];
                    u4 w;
                    if (kind == 1) {
                        typedef _Float16 h2 __attribute__((ext_vector_type(2)));
                        float r[8];
#pragma unroll
                        for (int e = 0; e < 4; ++e) { const float l0 = lbv[bj][0][e], l1 = lbv[bj][1][e];
                            r[e] = __logf(l0 + (1.0f - l0) * sigm(v0[e])); r[4 + e] = __logf(l1 + (1.0f - l1) * sigm(v1[e])); }
                        h2 a = {(_Float16)r[0], (_Float16)r[1]}, b = {(_Float16)r[2], (_Float16)r[3]}, c = {(_Float16)r[4], (_Float16)r[5]}, d = {(_Float16)r[6], (_Float16)r[7]};
                        w.x = __builtin_bit_cast(unsigned, a); w.y = __builtin_bit_cast(unsigned, b); w.z = __builtin_bit_cast(unsigned, c); w.w = __builtin_bit_cast(unsigned, d);
                    } else {
                        if (kind == 0) { v0 = map_silu(v0); v1 = map_silu(v1); }
                        else if (kind == 3) { v0 = v0 * QSCALE; v1 = v1 * QSCALE; }
                        else if (kind == 4 || kind == 5) { v0 = map_sigm(v0); v1 = map_sigm(v1); }
                        else if (kind == 6) { f4 o0, o1; unpack8(*(const u4*)(rowp + bj * HALF), o0, o1); v0 = map_silu(v0) * o0; v1 = map_silu(v1) * o1; }
                        w = pack8(v0, v1);
                    }
                    *(u4*)(rowp + bj * HALF) = w;
                }
            }
    }
};

struct EpiGateMul {
    static constexpr bool PERM = true, AFTER_DRAIN = false;
    const unsigned short* gate; unsigned short* out; int addprev;
    __device__ __forceinline__ void operator()(const f4 (&acc)[2][2][4][2], const Unit& u, int wr, int wc, int fr, int fq) const {
        const int row0 = u.pm * BM + wr * 64 + fr, col0 = u.pn * BM + wc * 32 + 8 * fq;
#pragma unroll
        for (int ai = 0; ai < 2; ++ai)
#pragma unroll
            for (int m = 0; m < 4; ++m) {
                const size_t off = (size_t)(row0 + ai * HALF + m * 16) * 1024 + col0;
#pragma unroll
                for (int bj = 0; bj < 2; ++bj) {
                    f4 g0, g1; unpack8(*(const u4*)(gate + off + bj * HALF), g0, g1);
                    f4 v0 = acc[ai][bj][m][0] * g0, v1 = acc[ai][bj][m][1] * g1;
                    if (addprev) { f4 p0, p1; unpack8(*(const u4*)(out + off + bj * HALF), p0, p1); v0 = v0 + p0; v1 = v1 + p1; }
                    *(u4*)(out + off + bj * HALF) = pack8(v0, v1);
                }
            }
    }
};

struct EpiRowScale {
    static constexpr bool PERM = true, AFTER_DRAIN = false;
    const float* ss; unsigned short* out; int ldc; float scale;
    __device__ __forceinline__ void operator()(const f4 (&acc)[2][2][4][2], const Unit& u, int wr, int wc, int fr, int fq) const {
        const int row0 = u.pm * BM + wr * 64 + fr, col0 = u.pn * BM + wc * 32 + 8 * fq;
#pragma unroll
        for (int ai = 0; ai < 2; ++ai)
#pragma unroll
            for (int m = 0; m < 4; ++m) {
                const int row = row0 + ai * HALF + m * 16;
                const float rs = __builtin_amdgcn_rsqf(ss[row] * (1.0f / 1024.0f) + EPS) * scale;
#pragma unroll
                for (int bj = 0; bj < 2; ++bj)
                    *(u4*)(out + (size_t)row * ldc + col0 + bj * HALF) = pack8(acc[ai][bj][m][0] * rs, acc[ai][bj][m][1] * rs);
            }
    }
};

struct EpiStore {
    static constexpr bool PERM = true, AFTER_DRAIN = false;
    unsigned short* out; int ldc;
    __device__ __forceinline__ void operator()(const f4 (&acc)[2][2][4][2], const Unit& u, int wr, int wc, int fr, int fq) const {
        const int row0 = u.pm * BM + wr * 64 + fr, col0 = u.pn * BM + wc * 32 + 8 * fq;
#pragma unroll
        for (int ai = 0; ai < 2; ++ai)
#pragma unroll
            for (int m = 0; m < 4; ++m)
#pragma unroll
                for (int bj = 0; bj < 2; ++bj)
                    *(u4*)(out + (size_t)(row0 + ai * HALF + m * 16) * ldc + col0 + bj * HALF) = pack8(acc[ai][bj][m][0], acc[ai][bj][m][1]);
    }
};

struct EpiSwiglu {
    static constexpr bool PERM = true, AFTER_DRAIN = false;
    const float* ss; unsigned short* out;
    __device__ __forceinline__ void operator()(const f4 (&acc)[2][2][4][2], const Unit& u, int wr, int wc, int fr, int fq) const {
        const int row0 = u.pm * BM + wr * 64 + fr, col0 = u.pn * HALF + wc * 32 + 8 * fq;
#pragma unroll
        for (int ai = 0; ai < 2; ++ai)
#pragma unroll
            for (int m = 0; m < 4; ++m) {
                const int row = row0 + ai * HALF + m * 16;
                const float rs = __builtin_amdgcn_rsqf(ss[row] * (1.0f / 1024.0f) + EPS);
                const f4 g0 = acc[ai][0][m][0] * rs, g1 = acc[ai][0][m][1] * rs, u0 = acc[ai][1][m][0] * rs, u1 = acc[ai][1][m][1] * rs;
                *(u4*)(out + (size_t)row * DFF + col0) = pack8(map_silu(g0) * u0, map_silu(g1) * u1);
            }
    }
};

struct EpiResid {
    static constexpr bool PERM = false, AFTER_DRAIN = false;
    const float* base; float* hout; const float* g; unsigned short* hg; float* ssq;
    __device__ __forceinline__ void operator()(const f4 (&acc)[2][2][4][2], const Unit& u, int wr, int wc, int fr, int fq) const {
        const int row0 = u.pm * BM + wr * 64 + fr, col0 = u.pn * BM + wc * 32 + 4 * fq;
        f4 gv[2][2];
#pragma unroll
        for (int bj = 0; bj < 2; ++bj)
#pragma unroll
            for (int n = 0; n < 2; ++n) gv[bj][n] = hg ? *(const f4*)(g + col0 + bj * HALF + n * 16) : (f4){0.f, 0.f, 0.f, 0.f};
#pragma unroll
        for (int ai = 0; ai < 2; ++ai)
#pragma unroll
            for (int m = 0; m < 4; ++m) {
                const int row = row0 + ai * HALF + m * 16;
                const size_t off = (size_t)row * 1024 + col0;
                float s = 0.f;
#pragma unroll
                for (int bj = 0; bj < 2; ++bj)
#pragma unroll
                    for (int n = 0; n < 2; ++n) {
                        const f4 h = *(const f4*)(base + off + bj * HALF + n * 16) + acc[ai][bj][m][n];
                        *(f4*)(hout + off + bj * HALF + n * 16) = h;
                        s += (h[0] * h[0] + h[1] * h[1]) + (h[2] * h[2] + h[3] * h[3]);
                        if (hg) { const f4 q = h * gv[bj][n]; v2u w; w.x = pk2(q[0], q[1]); w.y = pk2(q[2], q[3]); *(v2u*)(hg + off + bj * HALF + n * 16) = w; }
                    }
                s += __shfl_xor(s, 16); s += __shfl_xor(s, 32);
                if (fq == 0) unsafeAtomicAdd(ssq + row, s);
            }
    }
};
}

struct Frame {
    LAS unsigned char* lds;
    int tid, lane, wave, vcu, G;
    unsigned char* ws; unsigned char* dout;
};

__device__ __forceinline__ void transpose_item(const float* W, int ldw, int K, int c0, int ncols, bf16* WT, LAS float* scr, int kb, int nb, int lane) {
    const int k0 = 64 * kb, n0 = 32 * nb;
#pragma unroll 8
    for (int i = 0; i < 32; ++i) { const int kk = 2 * i + (lane >> 5); const int n = n0 + (lane & 31);
        scr[kk * 33 + (lane & 31)] = (n < ncols) ? W[(size_t)(k0 + kk) * ldw + c0 + n] : 0.f; }
    asm volatile("s_waitcnt lgkmcnt(0)" ::: "memory");
    const int c = lane & 7;
#pragma unroll
    for (int j = 0; j < 4; ++j) { const int n = (lane >> 3) + 8 * j; const LAS float* s = scr + (8 * c) * 33 + n;
        v4u o; o.x = pk2(s[0 * 33], s[1 * 33]); o.y = pk2(s[2 * 33], s[3 * 33]); o.z = pk2(s[4 * 33], s[5 * 33]); o.w = pk2(s[6 * 33], s[7 * 33]);
        if (n0 + n < ncols) *(GAS v4u*)(WT + (size_t)(n0 + n) * K + k0 + 8 * c) = o; }
    asm volatile("s_waitcnt lgkmcnt(0)" ::: "memory");
}
__device__ __forceinline__ void transpose_job(Frame& F, const float* W, int ldw, int K, int c0, int ncols, bf16* WT, int dst0, int mode, int& cursor) {
    LAS float* scr = (LAS float*)(F.lds + F.wave * 16384);
    const int nblk = (ncols + 31) / 32, nitems = (K / 64) * nblk;
    const int gw = F.vcu * NWAVES + F.wave, NGW = F.G * NWAVES;
    int first = (gw - cursor) % NGW; if (first < 0) first += NGW;
    for (int it = first; it < nitems; it += NGW) {
        const int kb = it / nblk, nb = it % nblk;
        const int n0 = 32 * nb;
        const int drow = (mode == 0) ? (dst0 + n0) : (256 * (n0 / 128) + dst0 + (n0 % 128));
        transpose_item(W, ldw, K, c0 + n0, ncols - n0, WT + (size_t)drow * K, scr, kb, 0, F.lane);
    }
    cursor = (cursor + nitems) % NGW;
}
__device__ __forceinline__ void rms_row_to_bf16(const float* xrow, const float* g, bf16* orow, int lane) {
    const GAS f32x4* xr = (const GAS f32x4*)xrow + lane;
    const GAS f32x4* gr = (const GAS f32x4*)g + lane;
    f32x4 v[4]; float s = 0.f;
#pragma unroll
    for (int j = 0; j < 4; ++j) { v[j] = xr[64 * j]; s += (v[j].x * v[j].x + v[j].y * v[j].y) + (v[j].z * v[j].z + v[j].w * v[j].w); }
    const float r = __builtin_amdgcn_rsqf(wave_sum(s) * (1.f / 1024.f) + EPS);
    GAS unsigned long long* o8 = (GAS unsigned long long*)orow + lane;
#pragma unroll
    for (int j = 0; j < 4; ++j) { const f32x4 gg = gr[64 * j];
        o8[64 * j] = (unsigned long long)pk2(v[j].x * r * gg.x, v[j].y * r * gg.y) | ((unsigned long long)pk2(v[j].z * r * gg.z, v[j].w * r * gg.w) << 32); }
}

__device__ __forceinline__ void hgrn_naive(Frame& F, const float* g_norm) {
    bf16* QA = (bf16*)(F.ws + WS_QA); const half_t* LOGF = (const half_t*)(F.ws + WS_LOGF); const bf16* IB = (const bf16*)(F.ws + WS_I);
    LAS float* red = (LAS float*)F.lds;
    LAS float* red2 = red + 512;
    const int v = F.tid & 127, kg = F.tid >> 7;
    for (int unit = F.vcu; unit < 64; unit += F.G) {
        const int b = unit >> 3, h = unit & 7;
        float S[32];
#pragma unroll
        for (int j = 0; j < 32; ++j) S[j] = 0.f;
        const float gn = g_norm[v];
        for (int t = 0; t < T; ++t) {
            const size_t rowo = (size_t)(b * T + t) * 1024 + h * 128;
            const float iv = bf2f(IB[rowo + v]);
            float part = 0.f;
#pragma unroll
            for (int j8 = 0; j8 < 4; ++j8) {
                const v4u qw = *(const v4u*)(QA + rowo + kg * 32 + j8 * 8);
                const v4u lw = *(const v4u*)(LOGF + rowo + kg * 32 + j8 * 8);
                const unsigned qq[4] = {qw.x, qw.y, qw.z, qw.w}, ll[4] = {lw.x, lw.y, lw.z, lw.w};
#pragma unroll
                for (int e = 0; e < 4; ++e) {
                    typedef _Float16 h2 __attribute__((ext_vector_type(2)));
                    const h2 lh = __builtin_bit_cast(h2, ll[e]);
                    const float f0 = fast_exp((float)lh[0]), f1 = fast_exp((float)lh[1]);
                    const int j = j8 * 8 + 2 * e;
                    S[j] = f0 * S[j] + (1.0f - f0) * iv; part += S[j] * bflo(qq[e]);
                    S[j + 1] = f1 * S[j + 1] + (1.0f - f1) * iv; part += S[j + 1] * bfhi(qq[e]);
                }
            }
            red[kg * 128 + v] = part;
            __syncthreads();
            float o = 0.f;
            if (F.tid < 128) { o = (red[v] + red[128 + v]) + (red[256 + v] + red[384 + v]); const float ss = wave_sum(o * o); if (F.lane == 0) red2[F.wave] = ss; }
            __syncthreads();
            if (F.tid < 128) { const float r = __builtin_amdgcn_rsqf((red2[0] + red2[1]) * (1.0f / 128.0f) + EPS); QA[rowo + v] = (bf16)f2bf(o * r * gn); }
        }
        __syncthreads();
    }
}

__device__ __forceinline__ void compress_naive(Frame& F, const float* pe_k, const float* w1k, const float* w2k, const float* pe_v, const float* w1v, const float* w2v) {
    const bf16* KV = (const bf16*)(F.ws + WS_KV);
    LAS float* xs = (LAS float*)F.lds;
    LAS float* red = xs + 2048;
    LAS float* hs = red + 512;
    const int tid = F.tid;
    for (int it = F.vcu; it < NB * 4 * 127 * 2; it += F.G) {
        const int which = it & 1; int r = it >> 1; const int n = r % 127; r /= 127; const int g = r & 3, b = r >> 2;
        const float* pe = which ? pe_v : pe_k; const float* w1 = which ? w1v : w1k; const float* w2 = which ? w2v : w2k;
        for (int i = tid; i < 2048; i += NTHREADS) { const int l = i >> 6, d = i & 63;
            xs[i] = bf2f(KV[(size_t)(b * T + 16 * n + l) * 1536 + which * 256 + g * 64 + d]) + pe[i]; }
        __syncthreads();
        { const int j = tid & 127, part = tid >> 7; float a = 0.f;
          for (int i = part * 512; i < part * 512 + 512; ++i) a += xs[i] * w1[(size_t)i * 128 + j];
          red[part * 128 + j] = a; }
        __syncthreads();
        if (tid < 128) hs[tid] = silu((red[tid] + red[128 + tid]) + (red[256 + tid] + red[384 + tid]));
        __syncthreads();
        if (tid < 64) { float o = 0.f; for (int j = 0; j < 128; ++j) o += hs[j] * w2[j * 64 + tid];
            bf16* dst = (bf16*)(F.ws + (which ? WS_VC : WS_KC)); dst[((size_t)(b * 4 + g) * 128 + n) * 64 + tid] = (bf16)f2bf(o); }
        __syncthreads();
    }
}

__device__ __forceinline__ float dot64_bf(const LAS float* qs, const bf16* kr) {
    float d = 0.f;
#pragma unroll
    for (int k8 = 0; k8 < 8; ++k8) { const v4u w = *(const v4u*)(kr + k8 * 8);
        d += qs[k8 * 8] * bflo(w.x) + qs[k8 * 8 + 1] * bfhi(w.x) + qs[k8 * 8 + 2] * bflo(w.y) + qs[k8 * 8 + 3] * bfhi(w.y)
           + qs[k8 * 8 + 4] * bflo(w.z) + qs[k8 * 8 + 5] * bfhi(w.z) + qs[k8 * 8 + 6] * bflo(w.w) + qs[k8 * 8 + 7] * bfhi(w.w); }
    return d;
}
__device__ __forceinline__ void nsa_naive(Frame& F) {
    bf16* QATT = (bf16*)(F.ws + WS_QATT); const bf16* KV = (const bf16*)(F.ws + WS_KV); const bf16* KC = (const bf16*)(F.ws + WS_KC); const bf16* VC = (const bf16*)(F.ws + WS_VC);
    const bf16* GATES = (const bf16*)(F.ws + WS_GATES);
    const int sub = F.tid >> 8, w = (F.tid >> 6) & 3, lane = F.lane;
    LAS float* base = (LAS float*)(F.lds + sub * 16384);
    LAS float* q_s = base;
    LAS float* p_s = base + 256;
    LAS float* pc_s = base + 256 + 2048;
    LAS float* imp_s = pc_s + 512;
    LAS int* sel_s = (LAS int*)(imp_s + 32);
    for (int it0 = F.vcu * 2; it0 < NB * T * 4; it0 += F.G * 2) {
        const int it = it0 + sub; const int g = it & 3, t = (it >> 2) & (T - 1), b = it >> 13;
        const int h = g * 4 + w;
        const float slope2 = __builtin_amdgcn_exp2f(-0.5f * (float)(h + 1)) * LOG2E;
        const size_t row = (size_t)(b * T + t);
        q_s[w * 64 + lane] = bf2f(QATT[row * 1024 + h * 64 + lane]);
        __syncthreads();
        float s0 = -INFINITY, s1 = -INFINITY;
        { const int n0 = lane, n1 = lane + 64; const bf16* kcb = KC + (size_t)(b * 4 + g) * 128 * 64;
          if (16 * n0 + 31 <= t) s0 = dot64_bf(q_s + w * 64, kcb + n0 * 64) - slope2 * ((float)t - (16.0f * n0 + 15.5f));
          if (n1 < 127 && 16 * n1 + 31 <= t) s1 = dot64_bf(q_s + w * 64, kcb + n1 * 64) - slope2 * ((float)t - (16.0f * n1 + 15.5f)); }
        float mm = wave_max(fmaxf(s0, s1));
        if (!(mm > -INFINITY)) mm = 0.f;
        float p0 = __builtin_amdgcn_exp2f(s0 - mm), p1 = __builtin_amdgcn_exp2f(s1 - mm);
        float dsum = wave_sum(p0 + p1);
        if (!(dsum > 0.f)) dsum = 1.f;
        p0 /= dsum; p1 /= dsum;
        pc_s[w * 128 + lane] = p0; pc_s[w * 128 + 64 + lane] = p1;
        __syncthreads();
        float o_cmp = 0.f;
        { const bf16* vcb = VC + (size_t)(b * 4 + g) * 128 * 64;
          for (int n = 0; n < 127; ++n) o_cmp += pc_s[w * 128 + n] * bf2f(vcb[n * 64 + lane]); }
        if ((F.tid & 255) < 32) { const int s = F.tid & 255; float im = 0.f;
            for (int n = 4 * s - 1; n <= 4 * s + 3; ++n) if (n >= 0 && n < 127) im += ((pc_s[n] + pc_s[128 + n]) + pc_s[256 + n]) + pc_s[384 + n];
            imp_s[s] = im; }
        __syncthreads();
        if ((F.tid & 255) == 0) { const int cur = t >> 6; unsigned used = 0u; int cnt = 0;
            for (int i = 0; i < 8; ++i) { float best = -INFINITY; int bi = -1;
                for (int s = 0; s < 32; ++s) { if ((used >> s) & 1u) continue; if (64 * s > t) continue;
                    const float sc = imp_s[s] + ((s == 0 || s == cur || s == cur - 1) ? 1.0e4f : 0.0f); if (sc > best) { best = sc; bi = s; } }
                if (bi >= 0) used |= 1u << bi;
                sel_s[i] = bi; } }
        __syncthreads();
        float o_slc = 0.f;
        { float mx = -INFINITY;
          for (int i = 0; i < 8; ++i) { const int sb = sel_s[i]; const int kp = 64 * sb + lane; float sc = -INFINITY;
              if (sb >= 0 && kp <= t) sc = dot64_bf(q_s + w * 64, KV + (size_t)(b * T + kp) * 1536 + 512 + g * 64) - slope2 * (float)(t - kp);
              p_s[w * 512 + i * 64 + lane] = sc; mx = fmaxf(mx, sc); }
          mx = wave_max(mx);
          float sum = 0.f;
          for (int i = 0; i < 8; ++i) { const float e = __builtin_amdgcn_exp2f(p_s[w * 512 + i * 64 + lane] - mx); p_s[w * 512 + i * 64 + lane] = e; sum += e; }
          sum = wave_sum(sum);
          __syncthreads();
          for (int i = 0; i < 8; ++i) { const int sb = sel_s[i]; if (sb < 0) continue;
              const bf16* vb = KV + (size_t)(b * T + 64 * sb) * 1536 + 768 + g * 64 + lane;
              for (int kk = 0; kk < 64; ++kk) o_slc += p_s[w * 512 + i * 64 + kk] * bf2f(vb[(size_t)kk * 1536]); }
          o_slc /= sum; }
        __syncthreads();
        float o_win = 0.f;
        { float mx = -INFINITY;
          for (int i = 0; i < 8; ++i) { const int kp = t - 511 + i * 64 + lane; float sc = -INFINITY;
              if (kp >= 0) sc = dot64_bf(q_s + w * 64, KV + (size_t)(b * T + kp) * 1536 + 1024 + g * 64) - slope2 * (float)(t - kp);
              p_s[w * 512 + i * 64 + lane] = sc; mx = fmaxf(mx, sc); }
          mx = wave_max(mx);
          float sum = 0.f;
          for (int i = 0; i < 8; ++i) { const float e = __builtin_amdgcn_exp2f(p_s[w * 512 + i * 64 + lane] - mx); p_s[w * 512 + i * 64 + lane] = e; sum += e; }
          sum = wave_sum(sum);
          __syncthreads();
          for (int i = 0; i < 512; ++i) { const int kp = t - 511 + i; if (kp >= 0) o_win += p_s[w * 512 + i] * bf2f(KV[(size_t)(b * T + kp) * 1536 + 1280 + g * 64 + lane]); }
          o_win /= sum; }
        const float g0 = bf2f(GATES[row * 64 + h * 3 + 0]), g1 = bf2f(GATES[row * 64 + h * 3 + 1]), g2 = bf2f(GATES[row * 64 + h * 3 + 2]);
        QATT[row * 1024 + h * 64 + lane] = (bf16)f2bf(g0 * o_cmp + g1 * o_slc + g2 * o_win);
        __syncthreads();
    }
}

__device__ __forceinline__ void xattn_naive(Frame& F) {
    const bf16* QX = (const bf16*)(F.ws + WS_QX); const bf16* KVM = (const bf16*)(F.ws + WS_KVM); bf16* OX = (bf16*)(F.ws + WS_OX);
    const int sub = F.tid >> 8, t8 = F.tid & 255, lane = F.lane, w = (F.tid >> 6) & 3;
    LAS float* base = (LAS float*)(F.lds + sub * 4096);
    LAS float* q_s = base; LAS float* p_s = base + 128; LAS float* red = base + 384;
    for (int it0 = F.vcu * 2; it0 < NB * T * 4; it0 += F.G * 2) {
        const int it = it0 + sub; const int h = it & 3, t = (it >> 2) & (T - 1), b = it >> 13;
        const size_t row = (size_t)(b * T + t);
        if (t8 < 128) q_s[t8] = bf2f(QX[row * 512 + h * 128 + t8]);
        __syncthreads();
        const bf16* kr = KVM + (size_t)(b * NMEM + t8) * 1024 + h * 128;
        const float s = dot64_bf(q_s, kr) + dot64_bf(q_s + 64, kr + 64);
        float mx = wave_max(s);
        if (lane == 0) red[w] = mx;
        __syncthreads();
        mx = fmaxf(fmaxf(red[0], red[1]), fmaxf(red[2], red[3]));
        __syncthreads();
        const float e = __builtin_amdgcn_exp2f(s - mx);
        p_s[t8] = e;
        float sum = wave_sum(e);
        if (lane == 0) red[w] = sum;
        __syncthreads();
        sum = (red[0] + red[1]) + (red[2] + red[3]);
        if (t8 < 128) { float acc = 0.f;
            for (int mmi = 0; mmi < 256; ++mmi) acc += p_s[mmi] * bf2f(KVM[(size_t)(b * NMEM + mmi) * 1024 + 512 + h * 128 + t8]);
            OX[row * 512 + h * 128 + t8] = (bf16)f2bf(acc / sum); }
        __syncthreads();
    }
}

#ifndef MK_PER_PHASE_LAUNCH
#define MK_PER_PHASE_LAUNCH 0
#endif
constexpr int N_PHASES = 13;
struct Args { const float* in[24]; float* out; unsigned char* ws; int ph_lo, ph_hi; };

__global__ void __launch_bounds__(NTHREADS, 2) mk_fwd(Args args) {
    extern __shared__ __attribute__((aligned(16))) unsigned char lds_raw[];
    Frame F;
    F.lds = (LAS unsigned char*)lds_raw;
    F.tid = threadIdx.x; F.lane = F.tid & 63; F.wave = __builtin_amdgcn_readfirstlane(F.tid >> 6);
    F.G = gridDim.x; { const int bx = blockIdx.x; F.vcu = (F.G % 8 == 0) ? (bx % 8) * (F.G / 8) + bx / 8 : bx; }
    F.ws = args.ws; F.dout = (unsigned char*)args.out;
    volatile LAS unsigned* MISC = (volatile LAS unsigned*)(F.lds + MISC_OFF);
    for (int u = F.tid; u < (LDS_BYTES - RING_BYTES) / 4; u += NTHREADS) ((LAS unsigned*)(F.lds + RING_BYTES))[u] = 0u;
    __syncthreads();
    unsigned* ctl = (unsigned*)(F.ws + WS_CTL);
    XcdBarrier bar; bar.bar = ctl + CW_BAR; bar.x = 0; bar.st = nullptr;
    if (!MK_PER_PHASE_LAUNCH) bar = xcd_barrier_post(ctl + CW_BAR, MISC + 8);
    const int lo = args.ph_lo, hi = args.ph_hi;
#define IN(k) (lo <= (k) && (k) < hi)
#define SEAM(k) do { if (IN(k) && IN((k) + 1)) xcd_barrier(bar); } while (0)
    unsigned char* ws = F.ws;
    const float* x = args.in[0];
    float* hbuf = args.out;
    float* ss1 = (float*)(ws + CTL_SS1); float* ss2 = (float*)(ws + CTL_SS2); float* ss3 = (float*)(ws + CTL_SS3);
    const int gw = F.vcu * NWAVES + F.wave, NGW = F.G * NWAVES;

    if (IN(0)) {
        int cur = 0;
        const float* w_in = args.in[3];
        bf16* WIN = (bf16*)(ws + WS_WIN);
        transpose_job(F, w_in, INW, 1024, 0, 3072, WIN, 0, 0, cur);
        transpose_job(F, w_in, INW, 1024, 3072, 1024, WIN, 7936, 0, cur);
        transpose_job(F, w_in, INW, 1024, 4096, 2560, WIN, 3072, 0, cur);
        transpose_job(F, w_in, INW, 1024, 6656, 48, WIN, 7680, 0, cur);
        transpose_job(F, w_in, INW, 1024, 6704, 2048, WIN, 5632, 0, cur);
        transpose_job(F, args.in[12], 1024, 1024, 0, 1024, (bf16*)(ws + WS_WPR), 0, 0, cur);
        transpose_job(F, args.in[13], 1024, 1024, 0, 1024, (bf16*)(ws + WS_WPA), 0, 0, cur);
        transpose_job(F, args.in[14], 1024, 1024, 0, 1024, (bf16*)(ws + WS_WOUT), 0, 0, cur);
        transpose_job(F, args.in[17], 512, 1024, 0, 512, (bf16*)(ws + WS_WXQ), 0, 0, cur);
        transpose_job(F, args.in[18], 1024, 1024, 0, 1024, (bf16*)(ws + WS_WXKV), 0, 0, cur);
        transpose_job(F, args.in[19], 1024, 512, 0, 1024, (bf16*)(ws + WS_WXO), 0, 0, cur);
        __syncthreads();
        for (int m = gw; m < M; m += NGW) rms_row_to_bf16(x + (size_t)m * 1024, args.in[2], (bf16*)(ws + WS_A) + (size_t)m * 1024, F.lane);
        for (int m = gw; m < NB * NMEM; m += NGW) rms_row_to_bf16(args.in[1] + (size_t)m * 1024, args.in[16], (bf16*)(ws + WS_MEMN) + (size_t)m * 1024, F.lane);
        if (blockIdx.x == 0) { const float* lbr = args.in[4]; float* lb = (float*)(ws + WS_LB);
            for (int c = F.tid; c < 1024; c += NTHREADS) lb[c] = 1.0f / (1.0f + __expf(lbr[1024 + c] - lbr[c])); }
    }
    SEAM(0);
    if (IN(1)) {
        { pg8::Gemm g{(const pg8::bf16_t*)(ws + WS_A), (const pg8::bf16_t*)(ws + WS_WIN), M, 31 * 256, 1024}; pg8::StaticOrder S; S.init(M, 31 * 256, F.G, (int)blockIdx.x);
          epi::EpiInProj E{ws, F.dout, 0};
          pg8::gemm_phase<epi::EpiInProj, pg8::StaticOrder, true, true>(F.lds, g, S, E); }
        { pg8::Gemm g{(const pg8::bf16_t*)(ws + WS_MEMN), (const pg8::bf16_t*)(ws + WS_WXKV), NB * NMEM, 1024, 1024}; pg8::StaticOrder S; S.init(NB * NMEM, 1024, F.G, (int)blockIdx.x);
          epi::EpiStore E{(unsigned short*)(ws + WS_KVM), 1024};
          pg8::gemm_phase<epi::EpiStore, pg8::StaticOrder, true, true>(F.lds, g, S, E); }
    }
    SEAM(1);
    if (IN(2)) {
        if (F.vcu < 64) hgrn_naive(F, args.in[5]);
        else { Frame F2 = F; F2.vcu = F.vcu - 64; F2.G = F.G - 64; compress_naive(F2, args.in[6], args.in[7], args.in[8], args.in[9], args.in[10], args.in[11]); }
    }
    SEAM(2);
    if (IN(3)) {
        nsa_naive(F);
        { pg8::Gemm g{(const pg8::bf16_t*)(ws + WS_A), (const pg8::bf16_t*)(ws + WS_WIN) + (size_t)31 * 256 * 1024, M, 1024, 1024}; pg8::StaticOrder S; S.init(M, 1024, F.G, (int)blockIdx.x);
          epi::EpiInProj E{ws, F.dout, 31};
          pg8::gemm_phase<epi::EpiInProj, pg8::StaticOrder, true, true>(F.lds, g, S, E); }
    }
    SEAM(3);
    if (IN(4)) {
        { pg8::Gemm g{(const pg8::bf16_t*)(ws + WS_QATT), (const pg8::bf16_t*)(ws + WS_WPA), M, 1024, 1024}; pg8::StaticOrder S; S.init(M, 1024, F.G, (int)blockIdx.x);
          epi::EpiGateMul E{(const unsigned short*)(F.dout + 32 * MiB), (unsigned short*)(ws + WS_MERGED), 0};
          pg8::gemm_phase<epi::EpiGateMul, pg8::StaticOrder, true, true>(F.lds, g, S, E); }
        { pg8::Gemm g{(const pg8::bf16_t*)(ws + WS_QA), (const pg8::bf16_t*)(ws + WS_WPR), M, 1024, 1024}; pg8::StaticOrder S; S.init(M, 1024, F.G, (int)blockIdx.x);
          epi::EpiGateMul E{(const unsigned short*)(F.dout), (unsigned short*)(ws + WS_MERGED), 1};
          pg8::gemm_phase<epi::EpiGateMul, pg8::StaticOrder, true, true>(F.lds, g, S, E); }
    }
    SEAM(4);
    if (IN(5)) {
        { pg8::Gemm g{(const pg8::bf16_t*)(ws + WS_MERGED), (const pg8::bf16_t*)(ws + WS_WOUT), M, 1024, 1024}; pg8::StaticOrder S; S.init(M, 1024, F.G, (int)blockIdx.x);
          epi::EpiResid E{x, hbuf, args.in[15], (unsigned short*)(ws + WS_A), ss1};
          pg8::gemm_phase<epi::EpiResid, pg8::StaticOrder, true, true>(F.lds, g, S, E); }
        int cur = 0;
        transpose_job(F, args.in[21], 2 * DFF, 1024, 0, DFF, (bf16*)(ws + WS_WGU), 0, 1, cur);
        transpose_job(F, args.in[21], 2 * DFF, 1024, DFF, DFF, (bf16*)(ws + WS_WGU), 128, 1, cur);
        transpose_job(F, args.in[22], 1024, DFF, 0, 1024, (bf16*)(ws + WS_WDN), 0, 0, cur);
    }
    SEAM(5);
    if (IN(6)) {
        pg8::Gemm g{(const pg8::bf16_t*)(ws + WS_A), (const pg8::bf16_t*)(ws + WS_WXQ), M, 512, 1024}; pg8::StaticOrder S; S.init(M, 512, F.G, (int)blockIdx.x);
        epi::EpiRowScale E{ss1, (unsigned short*)(ws + WS_QX), 512, XSCALE};
        pg8::gemm_phase<epi::EpiRowScale, pg8::StaticOrder, true, true>(F.lds, g, S, E);
    }
    SEAM(6);
    if (IN(7)) xattn_naive(F);
    SEAM(7);
    if (IN(8)) {
        pg8::Gemm g{(const pg8::bf16_t*)(ws + WS_OX), (const pg8::bf16_t*)(ws + WS_WXO), M, 1024, 512}; pg8::StaticOrder S; S.init(M, 1024, F.G, (int)blockIdx.x);
        epi::EpiResid E{hbuf, hbuf, args.in[20], (unsigned short*)(ws + WS_QA), ss2};
        pg8::gemm_phase<epi::EpiResid, pg8::StaticOrder, true, true>(F.lds, g, S, E);
    }
    SEAM(8);
    if (IN(9)) {
        pg8::Gemm g{(const pg8::bf16_t*)(ws + WS_QA), (const pg8::bf16_t*)(ws + WS_WGU), M, 2 * DFF, 1024}; pg8::StaticOrder S; S.init(M, 2 * DFF, F.G, (int)blockIdx.x);
        epi::EpiSwiglu E{ss2, (unsigned short*)(ws + WS_ACT)};
        pg8::gemm_phase<epi::EpiSwiglu, pg8::StaticOrder, true, true>(F.lds, g, S, E);
    }
    SEAM(9);
    if (IN(10)) {
        pg8::Gemm g{(const pg8::bf16_t*)(ws + WS_ACT), (const pg8::bf16_t*)(ws + WS_WDN), M, 1024, DFF}; pg8::StaticOrder S; S.init(M, 1024, F.G, (int)blockIdx.x);
        epi::EpiResid E{hbuf, hbuf, nullptr, nullptr, ss3};
        pg8::gemm_phase<epi::EpiResid, pg8::StaticOrder, true, true>(F.lds, g, S, E);
    }
    SEAM(10);
    if (IN(11)) {
        const float* gf = args.in[23];
        for (int m = gw; m < M; m += NGW) {
            const float r = __builtin_amdgcn_rsqf(ss3[m] * (1.0f / 1024.0f) + EPS);
            GAS f32x4* hr = (GAS f32x4*)(hbuf + (size_t)m * 1024) + F.lane; const GAS f32x4* gr = (const GAS f32x4*)gf + F.lane;
#pragma unroll
            for (int j = 0; j < 4; ++j) { const f32x4 v = hr[64 * j], gg = gr[64 * j]; hr[64 * j] = v * r * gg; }
        }
    }
#undef IN
#undef SEAM
}

extern "C" void kernel_launch(void* const* d_in, const int* in_sizes, int n_in, void* d_out, int out_size, void* d_ws, size_t ws_size, hipStream_t stream) {
    static int grid = 0;
    if (grid == 0) {
        if (n_in != 24 || out_size != M * D || ws_size < WS_END) { fprintf(stderr, "kernel_launch: unexpected shapes (n_in %d out %d ws %zu)\n", n_in, out_size, ws_size); grid = -1; return; }
        int dev = 0, cus = 0, per_cu = 0;
        if (hipGetDevice(&dev) != hipSuccess || hipDeviceGetAttribute(&cus, hipDeviceAttributeMultiprocessorCount, dev) != hipSuccess) { grid = -1; return; }
        if (hipFuncSetAttribute((const void*)mk_fwd, hipFuncAttributeMaxDynamicSharedMemorySize, LDS_BYTES) != hipSuccess) { fprintf(stderr, "kernel_launch: hipFuncSetAttribute failed\n"); grid = -1; return; }
        if (hipOccupancyMaxActiveBlocksPerMultiprocessor(&per_cu, (const void*)mk_fwd, NTHREADS, LDS_BYTES) != hipSuccess || per_cu < 1) { fprintf(stderr, "kernel_launch: occupancy query says %d blocks per CU\n", per_cu); grid = -1; (void)hipGetLastError(); return; }
        (void)hipGetLastError();
        grid = cus;
    }
    if (grid < 0) return;
    if (hipMemsetAsync((char*)d_ws + WS_CTL, 0, CTL_ZERO_BYTES, stream) != hipSuccess) return;
    Args a{};
    for (int i = 0; i < 24; ++i) a.in[i] = (const float*)d_in[i];
    a.out = (float*)d_out; a.ws = (unsigned char*)d_ws;
#if MK_PER_PHASE_LAUNCH
    for (int p = 0; p < N_PHASES; ++p) { a.ph_lo = p; a.ph_hi = p + 1; hipLaunchKernelGGL(mk_fwd, dim3(grid), dim3(NTHREADS), LDS_BYTES, stream, a); }
#else
    a.ph_lo = 0; a.ph_hi = N_PHASES;
    hipLaunchKernelGGL(mk_fwd, dim3(grid), dim3(NTHREADS), LDS_BYTES, stream, a);
#endif
}
```

```cpp
#include <hip/hip_runtime.h>
#include <cstdio>
#include <cstdint>
namespace pg8 {
#define PG8_LAS __attribute__((address_space(3)))
typedef unsigned short bf16_t;
typedef short bf16x8 __attribute__((ext_vector_type(8)));
typedef float f32x4 __attribute__((ext_vector_type(4)));
typedef unsigned u32x4 __attribute__((ext_vector_type(4)));
constexpr int BM = 256, BK = 64, HALF = 128, HTB = HALF * BK * 2  , STAGE_BYTES = 8 * HTB, NXCD = 8, WGM = 8;

__host__ __device__ __forceinline__ int lds_byte(int r, int c) { const int st = (r >> 4) * 2 + (c >> 5), rr = r & 15, cc = c & 31, ob = rr * 64 + cc * 2; return st * 1024 + (ob ^ (((ob >> 9) & 1) << 5)); }
__host__ __device__ __forceinline__ void stage_rc(int b, int& R, int& C) { const int st = b / 1024, sb = b % 1024, swz = sb ^ (((sb >> 9) & 1) << 5); R = (st >> 1) * 16 + swz / 64; C = (st & 1) * 32 + (swz % 64) / 2; }
__host__ __device__ __forceinline__ int perm32(int rho) { const int n = rho >> 4, i = rho & 15; return 8 * (i >> 2) + 4 * n + (i & 3); }

struct Unit { int pm, pn; };
struct Gemm { const bf16_t* A; const bf16_t* Bt; int M, N, K; };

struct StaticOrder {
    int nM, nN, nwg, G, c;
    __host__ __device__ void init(int M, int N, int G_, int c_) { nM = M / BM; nN = N / BM; nwg = nM * nN; G = G_; c = c_; }
    __host__ __device__ bool next(int i, Unit& u) const {
        const long L = (long)i * G + c; if (L >= nwg) return false;
        int wgid = (int)L; { const int q = nwg / NXCD, r = nwg % NXCD, xcd = wgid % NXCD, off = wgid / NXCD; wgid = (xcd < r ? xcd * (q + 1) : r * (q + 1) + (xcd - r) * q) + off; }
        const int nig = WGM * nN, gid = wgid / nig, fm = gid * WGM, gsz = (nM - fm) < WGM ? (nM - fm) : WGM;
        u.pm = fm + ((wgid % nig) % gsz); u.pn = (wgid % nig) / gsz; return true;
    }
    __device__ __forceinline__ void a_ready(const Unit&) const {}
    __device__ __forceinline__ void done(const Unit&) const {}
};

__device__ __forceinline__ unsigned cvt_pk_bf16(float lo, float hi) { unsigned r; asm volatile("v_cvt_pk_bf16_f32 %0, %1, %2" : "=v"(r) : "v"(lo), "v"(hi)); return r; }
typedef float f32x2 __attribute__((ext_vector_type(2)));
__device__ __forceinline__ f32x2 gelu_pk(f32x2 v) {
    const f32x2 av = __builtin_elementwise_abs(v), d = av * 0.2316418882f + 1.0f;
    f32x2 t; t.x = __builtin_amdgcn_rcpf(d.x); t.y = __builtin_amdgcn_rcpf(d.y);
    f32x2 q = t * 0.5307027145f + (-0.7265760135f); q = q * t + 0.7107068705f; q = q * t + (-0.142248368f); q = q * t + 0.127414796f; q = q * t;
    const f32x2 s = (v * v) * (-0.72134752044f);
    f32x2 e; e.x = __builtin_amdgcn_exp2f(s.x); e.y = __builtin_amdgcn_exp2f(s.y);
    const f32x2 m = v * (q * e), r = v - m;
    f32x2 o; o.x = v.x < 0.f ? m.x : r.x; o.y = v.y < 0.f ? m.y : r.y; return o;
}

template <int ACT  > struct EpiBf16 {
    static constexpr bool PERM = true, AFTER_DRAIN = false; static_assert(ACT == 0 || ACT == 1, "EpiBf16: ACT is 0 (none) or 1 (gelu_pk)");
    bf16_t* O; int ldc; const float* bias; int split_cols; size_t split_stride; float scale0;
    __device__ __forceinline__ void operator()(const f32x4 (&acc)[2][2][4][2], const Unit& u, int wr, int wc, int fr, int fq) const {
        const int row0 = u.pm * BM + wr * 64 + fr; int colt = u.pn * BM; bf16_t* base = O;
        float sc = 1.f; if (split_cols) { const int t = colt / split_cols; base += (size_t)t * split_stride; colt -= t * split_cols; if (t == 0) sc = scale0; }
        const int col0 = colt + wc * 32 + 8 * fq, bcol0 = u.pn * BM + wc * 32 + 8 * fq;
        f32x4 bv[2][2];
#pragma unroll
        for (int bj = 0; bj < 2; ++bj)
#pragma unroll
            for (int n = 0; n < 2; ++n) bv[bj][n] = bias ? *(const f32x4*)(bias + bcol0 + bj * HALF + 4 * n) : (f32x4){0.f, 0.f, 0.f, 0.f};
#pragma unroll
        for (int ai = 0; ai < 2; ++ai)
#pragma unroll
            for (int m = 0; m < 4; ++m) { bf16_t* rowp = base + (size_t)(row0 + ai * HALF + m * 16) * ldc + col0;
#pragma unroll
                for (int bj = 0; bj < 2; ++bj) { f32x4 v0 = acc[ai][bj][m][0] + bv[bj][0], v1 = acc[ai][bj][m][1] + bv[bj][1];
                    if (ACT == 1) { f32x2 a = gelu_pk((f32x2){v0[0], v0[1]}), b = gelu_pk((f32x2){v0[2], v0[3]}), c = gelu_pk((f32x2){v1[0], v1[1]}), d = gelu_pk((f32x2){v1[2], v1[3]});
                        v0 = (f32x4){a.x, a.y, b.x, b.y}; v1 = (f32x4){c.x, c.y, d.x, d.y}; }
                    v0 = v0 * sc; v1 = v1 * sc; u32x4 w; w.x = cvt_pk_bf16(v0[0], v0[1]); w.y = cvt_pk_bf16(v0[2], v0[3]); w.z = cvt_pk_bf16(v1[0], v1[1]); w.w = cvt_pk_bf16(v1[2], v1[3]);
                    *(u32x4*)(rowp + bj * HALF) = w; } }
    }
};
template <class Epi, class Sched, bool ALIGN_EPI = false, bool SP2 = false>
__device__ __forceinline__ void gemm_phase(PG8_LAS unsigned char* lds, const Gemm g, const Sched& S, const Epi& E) {
    const int tid = threadIdx.x, wid = __builtin_amdgcn_readfirstlane(tid >> 6), lane = tid & 63, wr = wid >> 2, wc = wid & 3, fr = lane & 15, fq = lane >> 4;
    const int K = g.K, nt = K / BK;
    unsigned voffA[2], voffB[2];
#pragma unroll
    for (int i = 0; i < 2; ++i) { int R, C; stage_rc(tid * 16 + i * 8192, R, C); const int Rb = Epi::PERM ? ((R & ~31) + perm32(R & 31)) : R;
        voffA[i] = (unsigned)(R * K + C) * 2u; voffB[i] = (unsigned)(Rb * K + C) * 2u; }
    const size_t kstep = (size_t)(BK * 2);
    const size_t hstep = (size_t)HALF * K * 2;
    const size_t tstep = 2 * hstep;
    const unsigned ldsw = (unsigned)wid * 1024u;
    const int aoff = lds_byte(wr * 64 + fr, fq * 8), boff = lds_byte(wc * 32 + fr, fq * 8);
#define PG8_SA(b, h) (((b) * 2 + (h)) * HTB)
#define PG8_SB(b, h) ((4 + (b) * 2 + (h)) * HTB)
#define PG8_STAGE(bufoff, gbase, voff) do { _Pragma("unroll") for (int _i = 0; _i < 2; ++_i) \
        __builtin_amdgcn_global_load_lds((const unsigned*)((const char*)(gbase) + (voff)[_i]), (PG8_LAS unsigned*)(lds + (bufoff) + ldsw + _i * 8192), 16, 0, 0); } while (0)
#define PG8_LDA(dst, b, h) do { _Pragma("unroll") for (int m = 0; m < 4; ++m) _Pragma("unroll") for (int k = 0; k < 2; ++k) dst[m][k] = *(const PG8_LAS bf16x8*)(lds + PG8_SA(b, h) + aoff + m * 2048 + k * 1024); } while (0)
#define PG8_LDB(dst, b, h) do { _Pragma("unroll") for (int n = 0; n < 2; ++n) _Pragma("unroll") for (int k = 0; k < 2; ++k) dst[n][k] = *(const PG8_LAS bf16x8*)(lds + PG8_SB(b, h) + boff + n * 2048 + k * 1024); } while (0)
#define PG8_MMA(ai, bj, At, Bt) do { __builtin_amdgcn_s_setprio(1); _Pragma("unroll") for (int m = 0; m < 4; ++m) _Pragma("unroll") for (int n = 0; n < 2; ++n) _Pragma("unroll") for (int k = 0; k < 2; ++k) \
        acc[ai][bj][m][n] = __builtin_amdgcn_mfma_f32_16x16x32_bf16(Bt[n][k], At[m][k], acc[ai][bj][m][n], 0, 0, 0); __builtin_amdgcn_s_setprio(0); } while (0)
#define PG8_WAIT_V(n) asm volatile("s_waitcnt vmcnt(" #n ")" ::: "memory")
#define PG8_WAIT_L(n) asm volatile("s_waitcnt lgkmcnt(" #n ")" ::: "memory")
#define PG8_BAR __builtin_amdgcn_s_barrier()
#define PG8_SCHED __builtin_amdgcn_sched_barrier(0)
    Unit cur, nxt; int ui = 0;
    if (!S.next(0, cur)) return;
    f32x4 acc[2][2][4][2];
#pragma unroll
    for (int a = 0; a < 2; ++a)
#pragma unroll
        for (int b = 0; b < 2; ++b)
#pragma unroll
            for (int m = 0; m < 4; ++m)
#pragma unroll
                for (int n = 0; n < 2; ++n) acc[a][b][m][n] = (f32x4){0.f, 0.f, 0.f, 0.f};
    bf16x8 At[4][2], B0[2][2], B1[2][2];
    const char* cA = (const char*)g.A + (size_t)cur.pm * tstep; const char* cB = (const char*)g.Bt + (size_t)cur.pn * tstep;
    S.a_ready(cur);
    if constexpr (SP2) {
        PG8_STAGE(PG8_SB(0, 0), cB, voffB); PG8_STAGE(PG8_SB(0, 1), cB + hstep, voffB); PG8_STAGE(PG8_SA(0, 0), cA, voffA); PG8_STAGE(PG8_SA(0, 1), cA + hstep, voffA);
        if (wr == 1) PG8_BAR;
        PG8_WAIT_V(2); PG8_BAR;
        PG8_STAGE(PG8_SB(1, 0), cB + kstep, voffB); PG8_STAGE(PG8_SA(1, 0), cA + kstep, voffA); PG8_STAGE(PG8_SB(1, 1), cB + hstep + kstep, voffB);
        PG8_WAIT_V(6); PG8_BAR;
    } else {
        PG8_STAGE(PG8_SB(0, 0), cB, voffB); PG8_STAGE(PG8_SA(0, 0), cA, voffA); PG8_STAGE(PG8_SB(0, 1), cB + hstep, voffB); PG8_STAGE(PG8_SA(0, 1), cA + hstep, voffA);
        if (wr == 1) PG8_BAR;
        PG8_WAIT_V(4); PG8_BAR;
        PG8_STAGE(PG8_SB(1, 0), cB + kstep, voffB); PG8_STAGE(PG8_SA(1, 0), cA + kstep, voffA); PG8_STAGE(PG8_SB(1, 1), cB + hstep + kstep, voffB);
        PG8_WAIT_V(6); PG8_BAR;
    }
    for (;;) {
        const bool has_next = S.next(ui + 1, nxt);
        const char* nA = has_next ? (const char*)g.A + (size_t)nxt.pm * tstep : cA; const char* nB = has_next ? (const char*)g.Bt + (size_t)nxt.pn * tstep : cB;
        for (int t = 0; t < nt; t += 2) {
            const bool last = (t == nt - 2);
            const char* a1 = cA + (size_t)(t + 1) * kstep;
            const char* a2 = last ? nA : cA + (size_t)(t + 2) * kstep; const char* b2 = last ? nB : cB + (size_t)(t + 2) * kstep;
            const char* a3 = a2 + kstep; const char* b3 = b2 + kstep;
            if (last && has_next) S.a_ready(nxt);
            if constexpr (SP2) {
            PG8_LDB(B0, 0, 0); PG8_LDB(B1, 0, 1); PG8_SCHED; PG8_LDA(At, 0, 0); PG8_STAGE(PG8_SA(1, 1), a1 + hstep, voffA);
            PG8_WAIT_V(8); PG8_WAIT_L(0); PG8_BAR; PG8_MMA(0, 0, At, B0); PG8_MMA(0, 1, At, B1); PG8_BAR; PG8_SCHED;
            PG8_LDA(At, 0, 1); PG8_STAGE(PG8_SB(0, 0), b2, voffB); PG8_STAGE(PG8_SB(0, 1), b2 + hstep, voffB); PG8_STAGE(PG8_SA(0, 0), a2, voffA);
            PG8_WAIT_V(8); PG8_WAIT_L(0); PG8_BAR; PG8_MMA(1, 0, At, B0); PG8_MMA(1, 1, At, B1); PG8_BAR; PG8_SCHED;
            PG8_LDB(B0, 1, 0); PG8_LDB(B1, 1, 1); PG8_SCHED; PG8_LDA(At, 1, 0); PG8_STAGE(PG8_SA(0, 1), a2 + hstep, voffA);
            PG8_WAIT_V(8); PG8_WAIT_L(0); PG8_BAR; PG8_MMA(0, 0, At, B0); PG8_MMA(0, 1, At, B1); PG8_BAR; PG8_SCHED;
            PG8_LDA(At, 1, 1); PG8_STAGE(PG8_SB(1, 0), b3, voffB); PG8_STAGE(PG8_SB(1, 1), b3 + hstep, voffB); PG8_STAGE(PG8_SA(1, 0), a3, voffA);
            PG8_WAIT_V(8); PG8_WAIT_L(0); PG8_BAR; PG8_MMA(1, 0, At, B0); PG8_MMA(1, 1, At, B1); PG8_BAR; PG8_SCHED;
            } else {
            PG8_LDB(B0, 0, 0); PG8_SCHED; PG8_LDA(At, 0, 0); PG8_STAGE(PG8_SA(1, 1), a1 + hstep, voffA);
            PG8_WAIT_L(8); PG8_BAR; PG8_WAIT_L(0); PG8_MMA(0, 0, At, B0); PG8_BAR; PG8_SCHED;
            PG8_LDB(B1, 0, 1); PG8_STAGE(PG8_SB(0, 0), b2, voffB);
            PG8_BAR; PG8_WAIT_L(0); PG8_MMA(0, 1, At, B1); PG8_BAR;
            PG8_LDA(At, 0, 1); PG8_STAGE(PG8_SA(0, 0), a2, voffA);
            PG8_BAR; PG8_WAIT_L(0); PG8_MMA(1, 0, At, B0); PG8_BAR; PG8_SCHED;
            PG8_STAGE(PG8_SB(0, 1), b2 + hstep, voffB);
            PG8_WAIT_V(6); PG8_BAR; PG8_MMA(1, 1, At, B1); PG8_BAR;
            PG8_LDB(B0, 1, 0); PG8_SCHED; PG8_LDA(At, 1, 0); PG8_STAGE(PG8_SA(0, 1), a2 + hstep, voffA);
            PG8_WAIT_L(8); PG8_BAR; PG8_WAIT_L(0); PG8_MMA(0, 0, At, B0); PG8_BAR; PG8_SCHED;
            PG8_LDB(B1, 1, 1); PG8_STAGE(PG8_SB(1, 0), b3, voffB);
            PG8_BAR; PG8_WAIT_L(0); PG8_MMA(0, 1, At, B1); PG8_BAR;
            PG8_LDA(At, 1, 1); PG8_STAGE(PG8_SA(1, 0), a3, voffA);
            PG8_BAR; PG8_WAIT_L(0); PG8_MMA(1, 0, At, B0); PG8_BAR; PG8_SCHED;
            PG8_STAGE(PG8_SB(1, 1), b3 + hstep, voffB);
            PG8_WAIT_V(6); PG8_BAR; PG8_MMA(1, 1, At, B1); PG8_BAR;
            }
        }
        if constexpr (ALIGN_EPI) { if (wr == 0) PG8_BAR; }
        if constexpr (!Epi::AFTER_DRAIN) { E(acc, cur, wr, wc, fr, fq); S.done(cur); }
        if (!has_next) break;
#pragma unroll
        for (int a = 0; a < 2; ++a)
#pragma unroll
            for (int b = 0; b < 2; ++b)
#pragma unroll
                for (int m = 0; m < 4; ++m)
#pragma unroll
                    for (int n = 0; n < 2; ++n) acc[a][b][m][n] = (f32x4){0.f, 0.f, 0.f, 0.f};
        cur = nxt; cA = nA; cB = nB; ++ui;
        if constexpr (ALIGN_EPI) { if (wr == 1) PG8_BAR; }
    }
    PG8_WAIT_V(0);
    if constexpr (!ALIGN_EPI) { if (wr == 0) PG8_BAR; }
    PG8_BAR;
    if constexpr (Epi::AFTER_DRAIN) { E.fused(acc, cur, wr, wc, fr, fq, lds, wid, lane); S.done(cur); }
#undef PG8_SA
#undef PG8_SB
#undef PG8_STAGE
#undef PG8_LDA
#undef PG8_LDB
#undef PG8_MMA
#undef PG8_WAIT_V
#undef PG8_WAIT_L
#undef PG8_BAR
#undef PG8_SCHED
}
}

#define GAS __attribute__((address_space(1)))
#define LAS __attribute__((address_space(3)))
typedef unsigned short bf16;
typedef unsigned v4u __attribute__((ext_vector_type(4)));
typedef unsigned v2u __attribute__((ext_vector_type(2)));
typedef float f32x4 __attribute__((ext_vector_type(4)));
typedef float f32x16 __attribute__((ext_vector_type(16)));
typedef short bf16x8 __attribute__((ext_vector_type(8)));
typedef short s16x4 __attribute__((ext_vector_type(4)));
typedef _Float16 half_t;

constexpr int NWAVES = 8, NTHREADS = 512;
constexpr int M = 16384, D = 1024, T = 2048, NB = 8, NMEM = 256, DFF = 2816, INW = 8752;
constexpr float EPS = 1e-6f;
constexpr float LOG2E = 1.4426950408889634f;
constexpr float QSCALE = 0.125f * LOG2E;
constexpr float XSCALE = 0.08838834764831845f * LOG2E;

constexpr size_t MiB = 1u << 20;
constexpr size_t WS_CTL = 0, CTL_ZERO_BYTES = 1 * MiB;
constexpr size_t CTL_SS1 = 256 * 1024, CTL_SS2 = 320 * 1024, CTL_SS3 = 384 * 1024;
constexpr int CW_BAR = 4096;
constexpr size_t WS_LB = 1 * MiB;
constexpr size_t WS_WIN = 2 * MiB;
constexpr size_t WS_WPR = 20 * MiB, WS_WPA = 22 * MiB, WS_WOUT = 24 * MiB, WS_WXQ = 26 * MiB, WS_WXKV = 27 * MiB, WS_WXO = 29 * MiB;
constexpr size_t WS_WC1K = 30 * MiB, WS_WC1V = 30 * MiB + 512 * 1024;
constexpr size_t WS_KC = 31 * MiB, WS_VC = 31 * MiB + 512 * 1024;
constexpr size_t WS_KVM = 32 * MiB;
constexpr size_t WS_GATES = 36 * MiB;
constexpr size_t WS_MEMN = 38 * MiB;
constexpr size_t WS_A = 42 * MiB;
constexpr size_t WS_QA = 74 * MiB;
constexpr size_t WS_LOGF = 106 * MiB;
constexpr size_t WS_WGU = 106 * MiB, WS_WDN = 117 * MiB;
constexpr size_t WS_I = 138 * MiB;
constexpr size_t WS_MERGED = 138 * MiB, WS_QX = 138 * MiB, WS_OX = 154 * MiB;
constexpr size_t WS_QATT = 170 * MiB;
constexpr size_t WS_KV = 202 * MiB;
constexpr size_t WS_ACT = 138 * MiB;
constexpr size_t WS_END = 250 * MiB;
static_assert(WS_ACT + (size_t)M * DFF * 2 <= WS_END && WS_WDN + (size_t)1024 * DFF * 2 <= WS_I, "ws map");

constexpr int RING_BYTES = 131072;
constexpr int MISC_OFF = RING_BYTES + 320;
constexpr int LDS_BYTES = 147456;

#define RLX_AGENT __ATOMIC_RELAXED, __HIP_MEMORY_SCOPE_AGENT
__device__ __forceinline__ unsigned f2bf(float f) { unsigned u = __builtin_bit_cast(unsigned, f); return (u + 0x7fffu + ((u >> 16) & 1u)) >> 16; }
__device__ __forceinline__ unsigned pk2(float lo, float hi) { return f2bf(lo) | (f2bf(hi) << 16); }
__device__ __forceinline__ float bf2f(unsigned short b) { return __builtin_bit_cast(float, (unsigned)b << 16); }
__device__ __forceinline__ float bflo(unsigned w) { return __builtin_bit_cast(float, w << 16); }
__device__ __forceinline__ float bfhi(unsigned w) { return __builtin_bit_cast(float, w & 0xffff0000u); }
__device__ __forceinline__ float fast_exp(float x) { return __builtin_amdgcn_exp2f(x * LOG2E); }
__device__ __forceinline__ float fast_rcp(float x) { return __builtin_amdgcn_rcpf(x); }
__device__ __forceinline__ float sigm(float x) { return fast_rcp(1.0f + fast_exp(-x)); }
__device__ __forceinline__ float silu(float x) { return x * sigm(x); }
__device__ __forceinline__ float wave_sum(float v) {
#pragma unroll
    for (int o = 1; o < 64; o <<= 1) v += __shfl_xor(v, o);
    return v;
}
__device__ __forceinline__ float wave_max(float v) {
#pragma unroll
    for (int o = 1; o < 64; o <<= 1) v = fmaxf(v, __shfl_xor(v, o));
    return v;
}
#define XB_TMO      128
#define XB_XCNT(j)  (256  + 64 * (j))
#define XB_XSUB(j)  (1280 + 64 * (j))
#define XB_XGEN(j)  (2304 + 64 * (j))
#define XB_TOP      3328
#define XB_TOPGEN   3392
#define XCD_BAR_WORDS 3456
#define XB_SPIN_CAP (1u << 18)

__device__ __forceinline__ unsigned xb_ld(unsigned* p)              { return __hip_atomic_load(p, __ATOMIC_RELAXED, __HIP_MEMORY_SCOPE_AGENT); }
__device__ __forceinline__ unsigned xb_add(unsigned* p, unsigned v) { return __hip_atomic_fetch_add(p, v, __ATOMIC_RELAXED, __HIP_MEMORY_SCOPE_AGENT); }
__device__ __forceinline__ unsigned xb_xcc_id() { return (unsigned)__builtin_amdgcn_s_getreg((3 << 11) | 20) & 0xFu; }
#define XB_SPIN(cond, bar) do { unsigned _sp = 0; while (cond) { __builtin_amdgcn_s_sleep(1); \
    if ((++_sp & 255u) == 0u) { if (xb_ld(&(bar)[XB_TMO])) break; if (_sp > XB_SPIN_CAP) { atomicAdd(&(bar)[XB_TMO], 1u); break; } } } } while (0)

struct XcdBarrier {
    unsigned* bar; unsigned x;
    volatile LAS unsigned* st;
};

__device__ __forceinline__ XcdBarrier xcd_barrier_post(unsigned* bar, volatile LAS unsigned* st) {
    XcdBarrier b; b.bar = bar; b.x = xb_xcc_id(); b.st = st;
    if (threadIdx.x == 0) (void)xb_add(&bar[XB_XCNT(b.x)], 1u);
    return b;
}
__device__ __forceinline__ void xcd_barrier_complete(unsigned* bar, unsigned x, unsigned& nloc, unsigned& nx) {
    const unsigned G = gridDim.x * gridDim.y * gridDim.z;
    unsigned sum, cnt, mine, sp = 0u;
    for (;;) {
        sum = 0u; cnt = 0u; mine = 0u;
#pragma unroll
        for (unsigned j = 0; j < 16; ++j) { const unsigned c = xb_ld(&bar[XB_XCNT(j)]); sum += c; cnt += (c > 0u) ? 1u : 0u; mine = (j == x) ? c : mine; }
        if (sum == G) break;
        __builtin_amdgcn_s_sleep(1);
        if ((++sp & 255u) == 0u) { if (xb_ld(&bar[XB_TMO])) break; if (sp > XB_SPIN_CAP) { atomicAdd(&bar[XB_TMO], 1u); break; } }
    }
    nloc = mine > 0u ? mine : 1u; nx = cnt > 0u ? cnt : 1u;
}

__device__ __forceinline__ void xcd_barrier(const XcdBarrier& b) {
    asm volatile("s_waitcnt vmcnt(0)" ::: "memory");
    __syncthreads();
    if (threadIdx.x == 0) {
        unsigned* bar = b.bar;
        __builtin_amdgcn_s_waitcnt(0);
        unsigned nloc = b.st[0], nx = b.st[1];
        if (nloc == 0u) { xcd_barrier_complete(bar, b.x, nloc, nx); b.st[0] = nloc; b.st[1] = nx; }
        const unsigned old = xb_add(&bar[XB_XSUB(b.x)], 1u);
        const unsigned gen = old / nloc;
        if (old + 1u == (gen + 1u) * nloc) {
            __builtin_amdgcn_fence(__ATOMIC_RELEASE, "agent");
            asm volatile("s_waitcnt vmcnt(0)" ::: "memory");
            const unsigned og = xb_add(&bar[XB_TOP], 1u);
            const unsigned tg = og / nx;
            if (og + 1u == (tg + 1u) * nx) xb_add(&bar[XB_TOPGEN], 1u);
            else XB_SPIN(xb_ld(&bar[XB_TOPGEN]) == tg, bar);
            __builtin_amdgcn_fence(__ATOMIC_ACQUIRE, "agent");
            xb_add(&bar[XB_XGEN(b.x)], 1u);
            asm volatile("s_waitcnt vmcnt(0)" ::: "memory");
        } else {
            XB_SPIN(xb_ld(&bar[XB_XGEN(b.x)]) == gen, bar);
            __builtin_amdgcn_fence(__ATOMIC_ACQUIRE, "agent");
            asm volatile("s_waitcnt vmcnt(0)" ::: "memory");
        }
    }
    __syncthreads();
}

namespace epi {
using pg8::Unit; using pg8::HALF; using pg8::BM;
typedef pg8::f32x4 f4; typedef pg8::u32x4 u4;
__device__ __forceinline__ u4 pack8(f4 a, f4 b) { u4 w; w.x = pk2(a[0], a[1]); w.y = pk2(a[2], a[3]); w.z = pk2(b[0], b[1]); w.w = pk2(b[2], b[3]); return w; }
__device__ __forceinline__ void unpack8(u4 w, f4& a, f4& b) { a = (f4){bflo(w.x), bfhi(w.x), bflo(w.y), bfhi(w.y)}; b = (f4){bflo(w.z), bfhi(w.z), bflo(w.w), bfhi(w.w)}; }
__device__ __forceinline__ f4 map_sigm(f4 v) { return (f4){sigm(v[0]), sigm(v[1]), sigm(v[2]), sigm(v[3])}; }
__device__ __forceinline__ f4 map_silu(f4 v) { return (f4){silu(v[0]), silu(v[1]), silu(v[2]), silu(v[3])}; }

struct EpiInProj {
    static constexpr bool PERM = true, AFTER_DRAIN = false;
    unsigned char* ws; unsigned char* dout; int tile0;
    __device__ __forceinline__ void operator()(const f4 (&acc)[2][2][4][2], const Unit& u, int wr, int wc, int fr, int fq) const {
        const int ct = tile0 + u.pn;
        int kind, ldc, colt; unsigned short* base;
        if (ct < 4) { kind = 0; base = (unsigned short*)(ws + WS_QA); ldc = 1024; colt = ct * 256; }
        else if (ct < 8) { kind = 1; base = (unsigned short*)(ws + WS_LOGF); ldc = 1024; colt = (ct - 4) * 256; }
        else if (ct < 12) { kind = 2; base = (unsigned short*)(ws + WS_I); ldc = 1024; colt = (ct - 8) * 256; }
        else if (ct < 16) { kind = 3; base = (unsigned short*)(ws + WS_QATT); ldc = 1024; colt = (ct - 12) * 256; }
        else if (ct < 22) { kind = 2; base = (unsigned short*)(ws + WS_KV); ldc = 1536; colt = (ct - 16) * 256; }
        else if (ct < 26) { kind = 4; base = (unsigned short*)(dout); ldc = 1024; colt = (ct - 22) * 256; }
        else if (ct < 30) { kind = 4; base = (unsigned short*)(dout + 32 * MiB); ldc = 1024; colt = (ct - 26) * 256; }
        else if (ct == 30) { kind = 5; base = (unsigned short*)(ws + WS_GATES); ldc = 64; colt = 0; }
        else { kind = 6; base = (unsigned short*)(ws + WS_QA); ldc = 1024; colt = (ct - 31) * 256; }
        const int row0 = u.pm * BM + wr * 64 + fr;
        const int col0 = colt + wc * 32 + 8 * fq;
        f4 lbv[2][2];
        if (kind == 1) {
            const float* lb = (const float*)(ws + WS_LB);
#pragma unroll
            for (int bj = 0; bj < 2; ++bj)
#pragma unroll
                for (int n = 0; n < 2; ++n) lbv[bj][n] = *(const f4*)(lb + col0 + bj * HALF + 4 * n);
        }
        if (kind == 5 && wc >= 2) return;
#pragma unroll
        for (int ai = 0; ai < 2; ++ai)
#pragma unroll
            for (int m = 0; m < 4; ++m) {
                unsigned short* rowp = base + (size_t)(row0 + ai * HALF + m * 16) * ldc + col0;
#pragma unroll
                for (int bj = 0; bj < 2; ++bj) {
                    if (kind == 5 && bj == 1) continue;
                    f4 v0 = acc[ai][bj][m][0], v1 = acc[ai][bj][m][1];
                    u4 w;
                    if (kind == 1) {
                        typedef _Float16 h2 __attribute__((ext_vector_type(2)));
                        float r[8];
#pragma unroll
                        for (int e = 0; e < 4; ++e) { const float l0 = lbv[bj][0][e], l1 = lbv[bj][1][e];
                            r[e] = __logf(l0 + (1.0f - l0) * sigm(v0[e])); r[4 + e] = __logf(l1 + (1.0f - l1) * sigm(v1[e])); }
                        h2 a = {(_Float16)r[0], (_Float16)r[1]}, b = {(_Float16)r[2], (_Float16)r[3]}, c = {(_Float16)r[4], (_Float16)r[5]}, d = {(_Float16)r[6], (_Float16)r[7]};
                        w.x = __builtin_bit_cast(unsigned, a); w.y = __builtin_bit_cast(unsigned, b); w.z = __builtin_bit_cast(unsigned, c); w.w = __builtin_bit_cast(unsigned, d);
                    } else {
                        if (kind == 0) { v0 = map_silu(v0); v1 = map_silu(v1); }
                        else if (kind == 3) { v0 = v0 * QSCALE; v1 = v1 * QSCALE; }
                        else if (kind == 4 || kind == 5) { v0 = map_sigm(v0); v1 = map_sigm(v1); }
                        else if (kind == 6) { f4 o0, o1; unpack8(*(const u4*)(rowp + bj * HALF), o0, o1); v0 = map_silu(v0) * o0; v1 = map_silu(v1) * o1; }
                        w = pack8(v0, v1);
                    }
                    *(u4*)(rowp + bj * HALF) = w;
                }
            }
    }
};

struct EpiGateMul {
    static constexpr bool PERM = true, AFTER_DRAIN = false;
    const unsigned short* gate; unsigned short* out; int addprev;
    __device__ __forceinline__ void operator()(const f4 (&acc)[2][2][4][2], const Unit& u, int wr, int wc, int fr, int fq) const {
        const int row0 = u.pm * BM + wr * 64 + fr, col0 = u.pn * BM + wc * 32 + 8 * fq;
#pragma unroll
        for (int ai = 0; ai < 2; ++ai)
#pragma unroll
            for (int m = 0; m < 4; ++m) {
                const size_t off = (size_t)(row0 + ai * HALF + m * 16) * 1024 + col0;
#pragma unroll
                for (int bj = 0; bj < 2; ++bj) {
                    f4 g0, g1; unpack8(*(const u4*)(gate + off + bj * HALF), g0, g1);
                    f4 v0 = acc[ai][bj][m][0] * g0, v1 = acc[ai][bj][m][1] * g1;
                    if (addprev) { f4 p0, p1; unpack8(*(const u4*)(out + off + bj * HALF), p0, p1); v0 = v0 + p0; v1 = v1 + p1; }
                    *(u4*)(out + off + bj * HALF) = pack8(v0, v1);
                }
            }
    }
};

struct EpiRowScale {
    static constexpr bool PERM = true, AFTER_DRAIN = false;
    const float* ss; unsigned short* out; int ldc; float scale;
    __device__ __forceinline__ void operator()(const f4 (&acc)[2][2][4][2], const Unit& u, int wr, int wc, int fr, int fq) const {
        const int row0 = u.pm * BM + wr * 64 + fr, col0 = u.pn * BM + wc * 32 + 8 * fq;
#pragma unroll
        for (int ai = 0; ai < 2; ++ai)
#pragma unroll
            for (int m = 0; m < 4; ++m) {
                const int row = row0 + ai * HALF + m * 16;
                const float rs = __builtin_amdgcn_rsqf(ss[row] * (1.0f / 1024.0f) + EPS) * scale;
#pragma unroll
                for (int bj = 0; bj < 2; ++bj)
                    *(u4*)(out + (size_t)row * ldc + col0 + bj * HALF) = pack8(acc[ai][bj][m][0] * rs, acc[ai][bj][m][1] * rs);
            }
    }
};

struct EpiStore {
    static constexpr bool PERM = true, AFTER_DRAIN = false;
    unsigned short* out; int ldc;
    __device__ __forceinline__ void operator()(const f4 (&acc)[2][2][4][2], const Unit& u, int wr, int wc, int fr, int fq) const {
        const int row0 = u.pm * BM + wr * 64 + fr, col0 = u.pn * BM + wc * 32 + 8 * fq;
#pragma unroll
        for (int ai = 0; ai < 2; ++ai)
#pragma unroll
            for (int m = 0; m < 4; ++m)
#pragma unroll
                for (int bj = 0; bj < 2; ++bj)
                    *(u4*)(out + (size_t)(row0 + ai * HALF + m * 16) * ldc + col0 + bj * HALF) = pack8(acc[ai][bj][m][0], acc[ai][bj][m][1]);
    }
};

struct EpiSwiglu {
    static constexpr bool PERM = true, AFTER_DRAIN = false;
    const float* ss; unsigned short* out;
    __device__ __forceinline__ void operator()(const f4 (&acc)[2][2][4][2], const Unit& u, int wr, int wc, int fr, int fq) const {
        const int row0 = u.pm * BM + wr * 64 + fr, col0 = u.pn * HALF + wc * 32 + 8 * fq;
#pragma unroll
        for (int ai = 0; ai < 2; ++ai)
#pragma unroll
            for (int m = 0; m < 4; ++m) {
                const int row = row0 + ai * HALF + m * 16;
                const float rs = __builtin_amdgcn_rsqf(ss[row] * (1.0f / 1024.0f) + EPS);
                const f4 g0 = acc[ai][0][m][0] * rs, g1 = acc[ai][0][m][1] * rs, u0 = acc[ai][1][m][0] * rs, u1 = acc[ai][1][m][1] * rs;
                *(u4*)(out + (size_t)row * DFF + col0) = pack8(map_silu(g0) * u0, map_silu(g1) * u1);
            }
    }
};

struct EpiResid {
    static constexpr bool PERM = false, AFTER_DRAIN = false;
    const float* base; float* hout; const float* g; unsigned short* hg; float* ssq;
    __device__ __forceinline__ void operator()(const f4 (&acc)[2][2][4][2], const Unit& u, int wr, int wc, int fr, int fq) const {
        const int row0 = u.pm * BM + wr * 64 + fr, col0 = u.pn * BM + wc * 32 + 4 * fq;
        f4 gv[2][2];
#pragma unroll
        for (int bj = 0; bj < 2; ++bj)
#pragma unroll
            for (int n = 0; n < 2; ++n) gv[bj][n] = hg ? *(const f4*)(g + col0 + bj * HALF + n * 16) : (f4){0.f, 0.f, 0.f, 0.f};
#pragma unroll
        for (int ai = 0; ai < 2; ++ai)
#pragma unroll
            for (int m = 0; m < 4; ++m) {
                const int row = row0 + ai * HALF + m * 16;
                const size_t off = (size_t)row * 1024 + col0;
                float s = 0.f;
#pragma unroll
                for (int bj = 0; bj < 2; ++bj)
#pragma unroll
                    for (int n = 0; n < 2; ++n) {
                        const f4 h = *(const f4*)(base + off + bj * HALF + n * 16) + acc[ai][bj][m][n];
                        *(f4*)(hout + off + bj * HALF + n * 16) = h;
                        s += (h[0] * h[0] + h[1] * h[1]) + (h[2] * h[2] + h[3] * h[3]);
                        if (hg) { const f4 q = h * gv[bj][n]; v2u w; w.x = pk2(q[0], q[1]); w.y = pk2(q[2], q[3]); *(v2u*)(hg + off + bj * HALF + n * 16) = w; }
                    }
                s += __shfl_xor(s, 16); s += __shfl_xor(s, 32);
                if (fq == 0) unsafeAtomicAdd(ssq + row, s);
            }
    }
};
}

struct Frame {
    LAS unsigned char* lds;
    int tid, lane, wave, vcu, G;
    unsigned char* ws; unsigned char* dout;
};

__device__ __forceinline__ void transpose_item(const float* W, int ldw, int K, int c0, int ncols, bf16* WT, LAS float* scr, int kb, int nb, int lane) {
    const int k0 = 64 * kb, n0 = 32 * nb;
#pragma unroll 8
    for (int i = 0; i < 32; ++i) { const int kk = 2 * i + (lane >> 5); const int n = n0 + (lane & 31);
        scr[kk * 33 + (lane & 31)] = (n < ncols) ? W[(size_t)(k0 + kk) * ldw + c0 + n] : 0.f; }
    asm volatile("s_waitcnt lgkmcnt(0)" ::: "memory");
    const int c = lane & 7;
#pragma unroll
    for (int j = 0; j < 4; ++j) { const int n = (lane >> 3) + 8 * j; const LAS float* s = scr + (8 * c) * 33 + n;
        v4u o; o.x = pk2(s[0 * 33], s[1 * 33]); o.y = pk2(s[2 * 33], s[3 * 33]); o.z = pk2(s[4 * 33], s[5 * 33]); o.w = pk2(s[6 * 33], s[7 * 33]);
        if (n0 + n < ncols) *(GAS v4u*)(WT + (size_t)(n0 + n) * K + k0 + 8 * c) = o; }
    asm volatile("s_waitcnt lgkmcnt(0)" ::: "memory");
}
__device__ __forceinline__ void transpose_job(Frame& F, const float* W, int ldw, int K, int c0, int ncols, bf16* WT, int dst0, int mode, int& cursor) {
    LAS float* scr = (LAS float*)(F.lds + F.wave * 16384);
    const int nblk = (ncols + 31) / 32, nitems = (K / 64) * nblk;
    const int gw = F.vcu * NWAVES + F.wave, NGW = F.G * NWAVES;
    int first = (gw - cursor) % NGW; if (first < 0) first += NGW;
    for (int it = first; it < nitems; it += NGW) {
        const int kb = it / nblk, nb = it % nblk;
        const int n0 = 32 * nb;
        const int drow = (mode == 0) ? (dst0 + n0) : (256 * (n0 / 128) + dst0 + (n0 % 128));
        transpose_item(W, ldw, K, c0 + n0, ncols - n0, WT + (size_t)drow * K, scr, kb, 0, F.lane);
    }
    cursor = (cursor + nitems) % NGW;
}
__device__ __forceinline__ void rms_row_to_bf16(const float* xrow, const float* g, bf16* orow, int lane) {
    const GAS f32x4* xr = (const GAS f32x4*)xrow + lane;
    const GAS f32x4* gr = (const GAS f32x4*)g + lane;
    f32x4 v[4]; float s = 0.f;
#pragma unroll
    for (int j = 0; j < 4; ++j) { v[j] = xr[64 * j]; s += (v[j].x * v[j].x + v[j].y * v[j].y) + (v[j].z * v[j].z + v[j].w * v[j].w); }
    const float r = __builtin_amdgcn_rsqf(wave_sum(s) * (1.f / 1024.f) + EPS);
    GAS unsigned long long* o8 = (GAS unsigned long long*)orow + lane;
#pragma unroll
    for (int j = 0; j < 4; ++j) { const f32x4 gg = gr[64 * j];
        o8[64 * j] = (unsigned long long)pk2(v[j].x * r * gg.x, v[j].y * r * gg.y) | ((unsigned long long)pk2(v[j].z * r * gg.z, v[j].w * r * gg.w) << 32); }
}

__device__ __forceinline__ void hgrn_naive(Frame& F, const float* g_norm) {
    bf16* QA = (bf16*)(F.ws + WS_QA); const half_t* LOGF = (const half_t*)(F.ws + WS_LOGF); const bf16* IB = (const bf16*)(F.ws + WS_I);
    LAS float* red = (LAS float*)F.lds;
    LAS float* red2 = red + 512;
    const int v = F.tid & 127, kg = F.tid >> 7;
    for (int unit = F.vcu; unit < 64; unit += F.G) {
        const int b = unit >> 3, h = unit & 7;
        float S[32];
#pragma unroll
        for (int j = 0; j < 32; ++j) S[j] = 0.f;
        const float gn = g_norm[v];
        for (int t = 0; t < T; ++t) {
            const size_t rowo = (size_t)(b * T + t) * 1024 + h * 128;
            const float iv = bf2f(IB[rowo + v]);
            float part = 0.f;
#pragma unroll
            for (int j8 = 0; j8 < 4; ++j8) {
                const v4u qw = *(const v4u*)(QA + rowo + kg * 32 + j8 * 8);
                const v4u lw = *(const v4u*)(LOGF + rowo + kg * 32 + j8 * 8);
                const unsigned qq[4] = {qw.x, qw.y, qw.z, qw.w}, ll[4] = {lw.x, lw.y, lw.z, lw.w};
#pragma unroll
                for (int e = 0; e < 4; ++e) {
                    typedef _Float16 h2 __attribute__((ext_vector_type(2)));
                    const h2 lh = __builtin_bit_cast(h2, ll[e]);
                    const float f0 = fast_exp((float)lh[0]), f1 = fast_exp((float)lh[1]);
                    const int j = j8 * 8 + 2 * e;
                    S[j] = f0 * S[j] + (1.0f - f0) * iv; part += S[j] * bflo(qq[e]);
                    S[j + 1] = f1 * S[j + 1] + (1.0f - f1) * iv; part += S[j + 1] * bfhi(qq[e]);
                }
            }
            red[kg * 128 + v] = part;
            __syncthreads();
            float o = 0.f;
            if (F.tid < 128) { o = (red[v] + red[128 + v]) + (red[256 + v] + red[384 + v]); const float ss = wave_sum(o * o); if (F.lane == 0) red2[F.wave] = ss; }
            __syncthreads();
            if (F.tid < 128) { const float r = __builtin_amdgcn_rsqf((red2[0] + red2[1]) * (1.0f / 128.0f) + EPS); QA[rowo + v] = (bf16)f2bf(o * r * gn); }
        }
        __syncthreads();
    }
}

__device__ __forceinline__ void compress_naive(Frame& F, const float* pe_k, const float* w1k, const float* w2k, const float* pe_v, const float* w1v, const float* w2v) {
    const bf16* KV = (const bf16*)(F.ws + WS_KV);
    LAS float* xs = (LAS float*)F.lds;
    LAS float* red = xs + 2048;
    LAS float* hs = red + 512;
    const int tid = F.tid;
    for (int it = F.vcu; it < NB * 4 * 127 * 2; it += F.G) {
        const int which = it & 1; int r = it >> 1; const int n = r % 127; r /= 127; const int g = r & 3, b = r >> 2;
        const float* pe = which ? pe_v : pe_k; const float* w1 = which ? w1v : w1k; const float* w2 = which ? w2v : w2k;
        for (int i = tid; i < 2048; i += NTHREADS) { const int l = i >> 6, d = i & 63;
            xs[i] = bf2f(KV[(size_t)(b * T + 16 * n + l) * 1536 + which * 256 + g * 64 + d]) + pe[i]; }
        __syncthreads();
        { const int j = tid & 127, part = tid >> 7; float a = 0.f;
          for (int i = part * 512; i < part * 512 + 512; ++i) a += xs[i] * w1[(size_t)i * 128 + j];
          red[part * 128 + j] = a; }
        __syncthreads();
        if (tid < 128) hs[tid] = silu((red[tid] + red[128 + tid]) + (red[256 + tid] + red[384 + tid]));
        __syncthreads();
        if (tid < 64) { float o = 0.f; for (int j = 0; j < 128; ++j) o += hs[j] * w2[j * 64 + tid];
            bf16* dst = (bf16*)(F.ws + (which ? WS_VC : WS_KC)); dst[((size_t)(b * 4 + g) * 128 + n) * 64 + tid] = (bf16)f2bf(o); }
        __syncthreads();
    }
}

__device__ __forceinline__ float dot64_bf(const LAS float* qs, const bf16* kr) {
    float d = 0.f;
#pragma unroll
    for (int k8 = 0; k8 < 8; ++k8) { const v4u w = *(const v4u*)(kr + k8 * 8);
        d += qs[k8 * 8] * bflo(w.x) + qs[k8 * 8 + 1] * bfhi(w.x) + qs[k8 * 8 + 2] * bflo(w.y) + qs[k8 * 8 + 3] * bfhi(w.y)
           + qs[k8 * 8 + 4] * bflo(w.z) + qs[k8 * 8 + 5] * bfhi(w.z) + qs[k8 * 8 + 6] * bflo(w.w) + qs[k8 * 8 + 7] * bfhi(w.w); }
    return d;
}
__device__ __forceinline__ void nsa_naive(Frame& F) {
    bf16* QATT = (bf16*)(F.ws + WS_QATT); const bf16* KV = (const bf16*)(F.ws + WS_KV); const bf16* KC = (const bf16*)(F.ws + WS_KC); const bf16* VC = (const bf16*)(F.ws + WS_VC);
    const bf16* GATES = (const bf16*)(F.ws + WS_GATES);
    const int sub = F.tid >> 8, w = (F.tid >> 6) & 3, lane = F.lane;
    LAS float* base = (LAS float*)(F.lds + sub * 16384);
    LAS float* q_s = base;
    LAS float* p_s = base + 256;
    LAS float* pc_s = base + 256 + 2048;
    LAS float* imp_s = pc_s + 512;
    LAS int* sel_s = (LAS int*)(imp_s + 32);
    for (int it0 = F.vcu * 2; it0 < NB * T * 4; it0 += F.G * 2) {
        const int it = it0 + sub; const int g = it & 3, t = (it >> 2) & (T - 1), b = it >> 13;
        const int h = g * 4 + w;
        const float slope2 = __builtin_amdgcn_exp2f(-0.5f * (float)(h + 1)) * LOG2E;
        const size_t row = (size_t)(b * T + t);
        q_s[w * 64 + lane] = bf2f(QATT[row * 1024 + h * 64 + lane]);
        __syncthreads();
        float s0 = -INFINITY, s1 = -INFINITY;
        { const int n0 = lane, n1 = lane + 64; const bf16* kcb = KC + (size_t)(b * 4 + g) * 128 * 64;
          if (16 * n0 + 31 <= t) s0 = dot64_bf(q_s + w * 64, kcb + n0 * 64) - slope2 * ((float)t - (16.0f * n0 + 15.5f));
          if (n1 < 127 && 16 * n1 + 31 <= t) s1 = dot64_bf(q_s + w * 64, kcb + n1 * 64) - slope2 * ((float)t - (16.0f * n1 + 15.5f)); }
        float mm = wave_max(fmaxf(s0, s1));
        if (!(mm > -INFINITY)) mm = 0.f;
        float p0 = __builtin_amdgcn_exp2f(s0 - mm), p1 = __builtin_amdgcn_exp2f(s1 - mm);
        float dsum = wave_sum(p0 + p1);
        if (!(dsum > 0.f)) dsum = 1.f;
        p0 /= dsum; p1 /= dsum;
        pc_s[w * 128 + lane] = p0; pc_s[w * 128 + 64 + lane] = p1;
        __syncthreads();
        float o_cmp = 0.f;
        { const bf16* vcb = VC + (size_t)(b * 4 + g) * 128 * 64;
          for (int n = 0; n < 127; ++n) o_cmp += pc_s[w * 128 + n] * bf2f(vcb[n * 64 + lane]); }
        if ((F.tid & 255) < 32) { const int s = F.tid & 255; float im = 0.f;
            for (int n = 4 * s - 1; n <= 4 * s + 3; ++n) if (n >= 0 && n < 127) im += ((pc_s[n] + pc_s[128 + n]) + pc_s[256 + n]) + pc_s[384 + n];
            imp_s[s] = im; }
        __syncthreads();
        if ((F.tid & 255) == 0) { const int cur = t >> 6; unsigned used = 0u; int cnt = 0;
            for (int i = 0; i < 8; ++i) { float best = -INFINITY; int bi = -1;
                for (int s = 0; s < 32; ++s) { if ((used >> s) & 1u) continue; if (64 * s > t) continue;
                    const float sc = imp_s[s] + ((s == 0 || s == cur || s == cur - 1) ? 1.0e4f : 0.0f); if (sc > best) { best = sc; bi = s; } }
                if (bi >= 0) used |= 1u << bi;
                sel_s[i] = bi; } }
        __syncthreads();
        float o_slc = 0.f;
        { float mx = -INFINITY;
          for (int i = 0; i < 8; ++i) { const int sb = sel_s[i]; const int kp = 64 * sb + lane; float sc = -INFINITY;
              if (sb >= 0 && kp <= t) sc = dot64_bf(q_s + w * 64, KV + (size_t)(b * T + kp) * 1536 + 512 + g * 64) - slope2 * (float)(t - kp);
              p_s[w * 512 + i * 64 + lane] = sc; mx = fmaxf(mx, sc); }
          mx = wave_max(mx);
          float sum = 0.f;
          for (int i = 0; i < 8; ++i) { const float e = __builtin_amdgcn_exp2f(p_s[w * 512 + i * 64 + lane] - mx); p_s[w * 512 + i * 64 + lane] = e; sum += e; }
          sum = wave_sum(sum);
          __syncthreads();
          for (int i = 0; i < 8; ++i) { const int sb = sel_s[i]; if (sb < 0) continue;
              const bf16* vb = KV + (size_t)(b * T + 64 * sb) * 1536 + 768 + g * 64 + lane;
              for (int kk = 0; kk < 64; ++kk) o_slc += p_s[w * 512 + i * 64 + kk] * bf2f(vb[(size_t)kk * 1536]); }
          o_slc /= sum; }
        __syncthreads();
        float o_win = 0.f;
        { float mx = -INFINITY;
          for (int i = 0; i < 8; ++i) { const int kp = t - 511 + i * 64 + lane; float sc = -INFINITY;
              if (kp >= 0) sc = dot64_bf(q_s + w * 64, KV + (size_t)(b * T + kp) * 1536 + 1024 + g * 64) - slope2 * (float)(t - kp);
              p_s[w * 512 + i * 64 + lane] = sc; mx = fmaxf(mx, sc); }
          mx = wave_max(mx);
          float sum = 0.f;
          for (int i = 0; i < 8; ++i) { const float e = __builtin_amdgcn_exp2f(p_s[w * 512 + i * 64 + lane] - mx); p_s[w * 512 + i * 64 + lane] = e; sum += e; }
          sum = wave_sum(sum);
          __syncthreads();
          for (int i = 0; i < 512; ++i) { const int kp = t - 511 + i; if (kp >= 0) o_win += p_s[w * 512 + i] * bf2f(KV[(size_t)(b * T + kp) * 1536 + 1280 + g * 64 + lane]); }
          o_win /= sum; }
        const float g0 = bf2f(GATES[row * 64 + h * 3 + 0]), g1 = bf2f(GATES[row * 64 + h * 3 + 1]), g2 = bf2f(GATES[row * 64 + h * 3 + 2]);
        QATT[row * 1024 + h * 64 + lane] = (bf16)f2bf(g0 * o_cmp + g1 * o_slc + g2 * o_win);
        __syncthreads();
    }
}

__device__ __forceinline__ void xattn_naive(Frame& F) {
    const bf16* QX = (const bf16*)(F.ws + WS_QX); const bf16* KVM = (const bf16*)(F.ws + WS_KVM); bf16* OX = (bf16*)(F.ws + WS_OX);
    const int sub = F.tid >> 8, t8 = F.tid & 255, lane = F.lane, w = (F.tid >> 6) & 3;
    LAS float* base = (LAS float*)(F.lds + sub * 4096);
    LAS float* q_s = base; LAS float* p_s = base + 128; LAS float* red = base + 384;
    for (int it0 = F.vcu * 2; it0 < NB * T * 4; it0 += F.G * 2) {
        const int it = it0 + sub; const int h = it & 3, t = (it >> 2) & (T - 1), b = it >> 13;
        const size_t row = (size_t)(b * T + t);
        if (t8 < 128) q_s[t8] = bf2f(QX[row * 512 + h * 128 + t8]);
        __syncthreads();
        const bf16* kr = KVM + (size_t)(b * NMEM + t8) * 1024 + h * 128;
        const float s = dot64_bf(q_s, kr) + dot64_bf(q_s + 64, kr + 64);
        float mx = wave_max(s);
        if (lane == 0) red[w] = mx;
        __syncthreads();
        mx = fmaxf(fmaxf(red[0], red[1]), fmaxf(red[2], red[3]));
        __syncthreads();
        const float e = __builtin_amdgcn_exp2f(s - mx);
        p_s[t8] = e;
        float sum = wave_sum(e);
        if (lane == 0) red[w] = sum;
        __syncthreads();
        sum = (red[0] + red[1]) + (red[2] + red[3]);
        if (t8 < 128) { float acc = 0.f;
            for (int mmi = 0; mmi < 256; ++mmi) acc += p_s[mmi] * bf2f(KVM[(size_t)(b * NMEM + mmi) * 1024 + 512 + h * 128 + t8]);
            OX[row * 512 + h * 128 + t8] = (bf16)f2bf(acc / sum); }
        __syncthreads();
    }
}

namespace nsa {
constexpr int KS = 72, VS = 96;
constexpr int KT_BYTES = 64 * KS * 2, VT_BYTES = 64 * VS * 2;
constexpr int L_K = 0, L_V = 2 * KT_BYTES, L_IMP = L_V + 2 * VT_BYTES, L_SEL = L_IMP + 64 * 33 * 4, L_UNI = L_SEL + 256, L_END = L_UNI + 16;
constexpr float NEG = -1.0e30f;
typedef short v4i16_t __attribute__((ext_vector_type(4)));

__device__ __forceinline__ int crow(int r, int hi) { return (r & 3) + 8 * (r >> 2) + 4 * hi; }
__device__ __forceinline__ float xhalf_max(float m) { auto rr = __builtin_amdgcn_permlane32_swap(__float_as_uint(m), __float_as_uint(m), false, false); return fmaxf(__uint_as_float(rr[0]), __uint_as_float(rr[1])); }
__device__ __forceinline__ float xhalf_sum(float m) { auto rr = __builtin_amdgcn_permlane32_swap(__float_as_uint(m), __float_as_uint(m), false, false); return __uint_as_float(rr[0]) + __uint_as_float(rr[1]); }

struct TileRegs { v4u k, v; };
__device__ __forceinline__ TileRegs load_tile(const bf16* Kg, const bf16* Vg, int ld, int tid) {
    const int row = tid >> 3, ch = tid & 7; TileRegs r;
    r.k = *(const v4u*)(Kg + (size_t)row * ld + ch * 8); r.v = *(const v4u*)(Vg + (size_t)row * ld + ch * 8); return r;
}
__device__ __forceinline__ void store_tile(LAS unsigned char* lds, int buf, const TileRegs& r, int tid) {
    const int row = tid >> 3, ch = tid & 7;
    *(LAS v4u*)(lds + L_K + buf * KT_BYTES + (row * KS + ch * 8) * 2) = r.k;
    *(LAS v4u*)(lds + L_V + buf * VT_BYTES + (row * VS + ch * 8) * 2) = r.v;
}
__device__ __forceinline__ void qk_tile(f32x16& p0, f32x16& p1, const LAS unsigned char* Kt, const bf16x8 (&qf)[4], int r32, int hi, float i0, float i1) {
#pragma unroll
    for (int r = 0; r < 16; ++r) { p0[r] = i0; p1[r] = i1; }
#pragma unroll
    for (int ks = 0; ks < 4; ++ks) {
        const bf16x8 a0 = *(const LAS bf16x8*)(Kt + (r32 * KS + 16 * ks + 8 * hi) * 2);
        const bf16x8 a1 = *(const LAS bf16x8*)(Kt + ((32 + r32) * KS + 16 * ks + 8 * hi) * 2);
        p0 = __builtin_amdgcn_mfma_f32_32x32x16_bf16(a0, qf[ks], p0, 0, 0, 0);
        p1 = __builtin_amdgcn_mfma_f32_32x32x16_bf16(a1, qf[ks], p1, 0, 0, 0);
    }
}
__device__ __forceinline__ bf16x8 pack_p(const f32x16& p, int s) {
    v4u w; w.x = pk2(p[8 * s + 0], p[8 * s + 1]); w.y = pk2(p[8 * s + 2], p[8 * s + 3]); w.z = pk2(p[8 * s + 4], p[8 * s + 5]); w.w = pk2(p[8 * s + 6], p[8 * s + 7]);
    return __builtin_bit_cast(bf16x8, w);
}
__device__ __forceinline__ s16x4 tr_read(const LAS unsigned char* p) { return __builtin_bit_cast(s16x4, __builtin_amdgcn_ds_read_tr16_b64_v4i16((LAS v4i16_t*)p)); }
template <int NDB>
__device__ __forceinline__ void pv_tile(f32x16 (&o)[NDB], const LAS unsigned char* Vt, int vstride, const f32x16& p0, const f32x16& p1, int lane) {
    const int hi = lane >> 5, i16 = lane & 15, g1 = (lane >> 4) & 1;
    const LAS unsigned char* vb = Vt + ((4 * hi + (i16 >> 2)) * vstride + 16 * g1 + 4 * (i16 & 3)) * 2;
#pragma unroll
    for (int half = 0; half < 2; ++half)
#pragma unroll
        for (int s = 0; s < 2; ++s) {
            const bf16x8 pf = pack_p(half ? p1 : p0, s);
#pragma unroll
            for (int db = 0; db < NDB; ++db) {
                const LAS unsigned char* a = vb + ((32 * half + 16 * s) * vstride + 32 * db) * 2;
                const s16x4 lo = tr_read(a), hi4 = tr_read(a + 8 * vstride * 2);
                const bf16x8 vf = (bf16x8){lo[0], lo[1], lo[2], lo[3], hi4[0], hi4[1], hi4[2], hi4[3]};
                o[db] = __builtin_amdgcn_mfma_f32_32x32x16_bf16(vf, pf, o[db], 0, 0, 0);
            }
        }
}
__device__ __forceinline__ void softmax_step(f32x16& p0, f32x16& p1, float& m, float& l, f32x16 (&o)[2]) {
    float a = fmaxf(p0[0], p1[0]);
#pragma unroll
    for (int r = 1; r < 16; ++r) a = fmaxf(a, fmaxf(p0[r], p1[r]));
    a = xhalf_max(a);
    const float mn = fmaxf(m, a), alpha = __builtin_amdgcn_exp2f(m - mn);
    float s = 0.f;
#pragma unroll
    for (int r = 0; r < 16; ++r) { p0[r] = __builtin_amdgcn_exp2f(p0[r] - mn); p1[r] = __builtin_amdgcn_exp2f(p1[r] - mn); s += p0[r] + p1[r]; }
    s = xhalf_sum(s);
    l = l * alpha + s; m = mn;
#pragma unroll
    for (int r = 0; r < 16; ++r) { o[0][r] *= alpha; o[1][r] *= alpha; }
}

__device__ __forceinline__ void unit(Frame& F, int b, int g, int qb) {
    LAS unsigned char* lds = F.lds;
    const int tid = F.tid, lane = F.lane, w = F.wave, hg = w >> 1, qh = w & 1, r32 = lane & 31, hi = lane >> 5;
    const int h = g * 4 + hg, qq = qh * 32 + r32, t = 64 * qb + qq;
    const size_t row = (size_t)b * T + t;
    bf16* QATT = (bf16*)(F.ws + WS_QATT); const bf16* KV = (const bf16*)(F.ws + WS_KV);
    const float slope2 = __builtin_amdgcn_exp2f(-0.5f * (float)(h + 1)) * LOG2E;
    bf16x8 qf[4];
#pragma unroll
    for (int ks = 0; ks < 4; ++ks) qf[ks] = *(const bf16x8*)(QATT + row * 1024 + h * 64 + 16 * ks + 8 * hi);
    const float sl4h = slope2 * (float)(4 * hi);
    const bf16* GATES = (const bf16*)(F.ws + WS_GATES);
    const float g0 = bf2f(GATES[row * 64 + h * 3 + 0]), g1 = bf2f(GATES[row * 64 + h * 3 + 1]), g2 = bf2f(GATES[row * 64 + h * 3 + 2]);
    LAS float* impL = (LAS float*)(lds + L_IMP);
    for (int i = tid; i < 64 * 33; i += NTHREADS) impL[i] = 0.f;
    f32x16 y[2];
    {
        const int ntile = (qb >= 16) ? 2 : 1;
        const bf16* KC = (const bf16*)(F.ws + WS_KC) + (size_t)(b * 4 + g) * 128 * 64; const bf16* VC = (const bf16*)(F.ws + WS_VC) + (size_t)(b * 4 + g) * 128 * 64;
        for (int tau = 0; tau < ntile; ++tau) { const TileRegs tr = load_tile(KC + tau * 64 * 64, VC + tau * 64 * 64, 64, tid); store_tile(lds, tau, tr, tid); }
        __syncthreads();
        const float cj = slope2 * ((float)t - 15.5f);
        const float sl16 = 16.0f * slope2;
        float m = NEG, l = 0.f;
        for (int tau = 0; tau < ntile; ++tau) {
            f32x16 p0, p1; const float b0 = 16.0f * sl4h + (float)(1024 * tau) * slope2 - cj;
            qk_tile(p0, p1, lds + L_K + tau * KT_BYTES, qf, r32, hi, b0, b0 + 512.0f * slope2);
            float a = NEG;
#pragma unroll
            for (int r = 0; r < 16; ++r) { const int n0 = 64 * tau + crow(r, hi), n1 = n0 + 32;
                p0[r] = (16 * n0 + 31 <= t) ? fmaf(sl16, (float)crow(r, 0), p0[r]) : NEG;
                p1[r] = (16 * n1 + 31 <= t) ? fmaf(sl16, (float)crow(r, 0), p1[r]) : NEG;
                a = fmaxf(a, fmaxf(p0[r], p1[r])); }
            a = xhalf_max(a);
            const float mn = fmaxf(m, a); float sacc = 0.f;
#pragma unroll
            for (int r = 0; r < 16; ++r) { const int n0 = 64 * tau + crow(r, hi), n1 = n0 + 32;
                sacc += ((16 * n0 + 31 <= t) ? __builtin_amdgcn_exp2f(p0[r] - mn) : 0.f) + ((16 * n1 + 31 <= t) ? __builtin_amdgcn_exp2f(p1[r] - mn) : 0.f); }
            l = l * __builtin_amdgcn_exp2f(m - mn) + xhalf_sum(sacc); m = mn;
        }
        const float inv = (l > 0.f) ? 1.0f / l : 0.f;
        f32x16 o[2];
#pragma unroll
        for (int r = 0; r < 16; ++r) { o[0][r] = 0.f; o[1][r] = 0.f; }
        for (int tau = 0; tau < ntile; ++tau) {
            f32x16 p0, p1; const float b0 = 16.0f * sl4h + (float)(1024 * tau) * slope2 - cj;
            qk_tile(p0, p1, lds + L_K + tau * KT_BYTES, qf, r32, hi, b0, b0 + 512.0f * slope2);
#pragma unroll
            for (int r = 0; r < 16; ++r) { const int n0 = 64 * tau + crow(r, hi), n1 = n0 + 32;
                p0[r] = (16 * n0 + 31 <= t) ? __builtin_amdgcn_exp2f(fmaf(sl16, (float)crow(r, 0), p0[r]) - m) * inv : 0.f;
                p1[r] = (16 * n1 + 31 <= t) ? __builtin_amdgcn_exp2f(fmaf(sl16, (float)crow(r, 0), p1[r]) - m) * inv : 0.f; }
#pragma unroll
            for (int i = 0; i < 4; ++i) {
                const int s0 = 16 * tau + 2 * i + hi, s1 = s0 + 8;
                __hip_atomic_fetch_add(&impL[qq * 33 + s0], (p0[4 * i] + p0[4 * i + 1]) + (p0[4 * i + 2] + p0[4 * i + 3]), __ATOMIC_RELAXED, __HIP_MEMORY_SCOPE_WORKGROUP);
                __hip_atomic_fetch_add(&impL[qq * 33 + s0 + 1], p0[4 * i + 3], __ATOMIC_RELAXED, __HIP_MEMORY_SCOPE_WORKGROUP);
                __hip_atomic_fetch_add(&impL[qq * 33 + s1], (p1[4 * i] + p1[4 * i + 1]) + (p1[4 * i + 2] + p1[4 * i + 3]), __ATOMIC_RELAXED, __HIP_MEMORY_SCOPE_WORKGROUP);
                if (s1 + 1 < 32) __hip_atomic_fetch_add(&impL[qq * 33 + s1 + 1], p1[4 * i + 3], __ATOMIC_RELAXED, __HIP_MEMORY_SCOPE_WORKGROUP);
            }
            pv_tile<2>(o, lds + L_V + tau * VT_BYTES, VS, p0, p1, lane);
        }
#pragma unroll
        for (int r = 0; r < 16; ++r) { y[0][r] = o[0][r] * g0; y[1][r] = o[1][r] * g0; }
    }
    __syncthreads();
    if (w == 0) {
        unsigned mask;
        if (qb <= 7) mask = (2u << qb) - 1u;
        else {
            float iv[32];
#pragma unroll
            for (int s = 0; s < 32; ++s) iv[s] = impL[lane * 33 + s];
            mask = 1u | (1u << qb) | (1u << (qb - 1));
#pragma unroll 1
            for (int pick = 0; pick < 5; ++pick) { float best = -1.0f; int bi = 1;
#pragma unroll
                for (int s = 1; s < 31; ++s) { const bool ok = (s <= qb - 2) && !((mask >> s) & 1u) && (iv[s] > best); best = ok ? iv[s] : best; bi = ok ? s : bi; }
                mask |= 1u << bi; }
        }
        ((LAS unsigned*)(lds + L_SEL))[lane] = mask;
        unsigned un = mask;
#pragma unroll
        for (int o = 1; o < 64; o <<= 1) un |= (unsigned)__shfl_xor((int)un, o);
        if (lane == 0) *(LAS unsigned*)(lds + L_UNI) = un;
    }
    __syncthreads();
    const unsigned selm = ((const LAS unsigned*)(lds + L_SEL))[qq];
    const unsigned uni = *(const LAS unsigned*)(lds + L_UNI);
    {
        float m = NEG, l = 0.f; f32x16 o[2];
#pragma unroll
        for (int r = 0; r < 16; ++r) { o[0][r] = 0.f; o[1][r] = 0.f; }
        const bf16* Kb = KV + (size_t)b * T * 1536 + 512 + g * 64; const bf16* Vb = KV + (size_t)b * T * 1536 + 768 + g * 64;
        unsigned rem = uni; int j = __builtin_ctz(rem); rem &= rem - 1u; int buf = 0;
        { const TileRegs tr = load_tile(Kb + (size_t)(64 * j) * 1536, Vb + (size_t)(64 * j) * 1536, 1536, tid); store_tile(lds, 0, tr, tid); }
        __syncthreads();
        for (;;) {
            const bool has_next = rem != 0u; int jn = 0; TileRegs tr;
            if (has_next) { jn = __builtin_ctz(rem); rem &= rem - 1u; tr = load_tile(Kb + (size_t)(64 * jn) * 1536, Vb + (size_t)(64 * jn) * 1536, 1536, tid); }
            const float b0 = sl4h - slope2 * (float)(t - 64 * j);
            f32x16 p0, p1; qk_tile(p0, p1, lds + L_K + buf * KT_BYTES, qf, r32, hi, b0, b0 + 32.0f * slope2);
            const bool sel = (selm >> j) & 1u;
            if (j == qb) {
#pragma unroll
                for (int r = 0; r < 16; ++r) { const int kk = crow(r, hi);
                    p0[r] = (sel && kk <= qq) ? fmaf(slope2, (float)crow(r, 0), p0[r]) : NEG; p1[r] = (sel && kk + 32 <= qq) ? fmaf(slope2, (float)crow(r, 0), p1[r]) : NEG; }
            } else {
#pragma unroll
                for (int r = 0; r < 16; ++r) { p0[r] = sel ? fmaf(slope2, (float)crow(r, 0), p0[r]) : NEG; p1[r] = sel ? fmaf(slope2, (float)crow(r, 0), p1[r]) : NEG; }
            }
            softmax_step(p0, p1, m, l, o);
            pv_tile<2>(o, lds + L_V + buf * VT_BYTES, VS, p0, p1, lane);
            if (has_next) store_tile(lds, buf ^ 1, tr, tid);
            __syncthreads();
            if (!has_next) break;
            buf ^= 1; j = jn;
        }
        const float sc = g1 / l;
#pragma unroll
        for (int r = 0; r < 16; ++r) { y[0][r] += o[0][r] * sc; y[1][r] += o[1][r] * sc; }
    }
    {
        float m = NEG, l = 0.f; f32x16 o[2];
#pragma unroll
        for (int r = 0; r < 16; ++r) { o[0][r] = 0.f; o[1][r] = 0.f; }
        const bf16* Kb = KV + (size_t)b * T * 1536 + 1024 + g * 64; const bf16* Vb = KV + (size_t)b * T * 1536 + 1280 + g * 64;
        const int jlast = (qb >= 8) ? qb - 8 : 0;
        int j = qb, buf = 0;
        { const TileRegs tr = load_tile(Kb + (size_t)(64 * j) * 1536, Vb + (size_t)(64 * j) * 1536, 1536, tid); store_tile(lds, 0, tr, tid); }
        __syncthreads();
        for (;;) {
            const bool has_next = j > jlast; TileRegs tr;
            if (has_next) tr = load_tile(Kb + (size_t)(64 * (j - 1)) * 1536, Vb + (size_t)(64 * (j - 1)) * 1536, 1536, tid);
            const float b0 = sl4h - slope2 * (float)(t - 64 * j);
            f32x16 p0, p1; qk_tile(p0, p1, lds + L_K + buf * KT_BYTES, qf, r32, hi, b0, b0 + 32.0f * slope2);
            if (j == qb) {
#pragma unroll
                for (int r = 0; r < 16; ++r) { const int kk = crow(r, hi);
                    p0[r] = (kk <= qq) ? fmaf(slope2, (float)crow(r, 0), p0[r]) : NEG; p1[r] = (kk + 32 <= qq) ? fmaf(slope2, (float)crow(r, 0), p1[r]) : NEG; }
            } else if (j == qb - 8) {
#pragma unroll
                for (int r = 0; r < 16; ++r) { const int kk = crow(r, hi);
                    p0[r] = (kk > qq) ? fmaf(slope2, (float)crow(r, 0), p0[r]) : NEG; p1[r] = (kk + 32 > qq) ? fmaf(slope2, (float)crow(r, 0), p1[r]) : NEG; }
            } else {
#pragma unroll
                for (int r = 0; r < 16; ++r) { p0[r] = fmaf(slope2, (float)crow(r, 0), p0[r]); p1[r] = fmaf(slope2, (float)crow(r, 0), p1[r]); }
            }
            softmax_step(p0, p1, m, l, o);
            pv_tile<2>(o, lds + L_V + buf * VT_BYTES, VS, p0, p1, lane);
            if (has_next) store_tile(lds, buf ^ 1, tr, tid);
            __syncthreads();
            if (!has_next) break;
            buf ^= 1; --j;
        }
        const float sc = g2 / l;
#pragma unroll
        for (int r = 0; r < 16; ++r) { y[0][r] += o[0][r] * sc; y[1][r] += o[1][r] * sc; }
    }
#pragma unroll
    for (int db = 0; db < 2; ++db)
#pragma unroll
        for (int i = 0; i < 4; ++i) { v2u wv; wv.x = pk2(y[db][4 * i], y[db][4 * i + 1]); wv.y = pk2(y[db][4 * i + 2], y[db][4 * i + 3]);
            *(v2u*)(QATT + row * 1024 + h * 64 + 32 * db + 8 * i + 4 * hi) = wv; }
}

__device__ __forceinline__ void phase(Frame& F) {
    for (int u = F.vcu; u < 1024; u += F.G) {
        const int slot = u >> 8, c = u & 255, bg = c >> 3, j = c & 7;
        const int qb = (slot == 0) ? 31 - j : (slot == 1) ? 16 + j : (slot == 2) ? 15 - j : j;
        unit(F, bg >> 2, bg & 3, qb);
        __syncthreads();
    }
}
}

namespace xat {
constexpr int KS = 136, VS = 160;
constexpr int KT_BYTES = 64 * KS * 2, VT_BYTES = 64 * VS * 2;
constexpr int L_K = 0, L_V = 2 * KT_BYTES;
struct TileRegs { v4u k[2], v[2]; };
__device__ __forceinline__ TileRegs load_tile(const bf16* Kg, const bf16* Vg, int tid) {
    const int row = tid >> 3, ch = tid & 7; TileRegs r;
    r.k[0] = *(const v4u*)(Kg + (size_t)row * 1024 + ch * 8); r.k[1] = *(const v4u*)(Kg + (size_t)row * 1024 + 64 + ch * 8);
    r.v[0] = *(const v4u*)(Vg + (size_t)row * 1024 + ch * 8); r.v[1] = *(const v4u*)(Vg + (size_t)row * 1024 + 64 + ch * 8); return r;
}
__device__ __forceinline__ void store_tile(LAS unsigned char* lds, int buf, const TileRegs& r, int tid) {
    const int row = tid >> 3, ch = tid & 7;
    *(LAS v4u*)(lds + L_K + buf * KT_BYTES + (row * KS + ch * 8) * 2) = r.k[0]; *(LAS v4u*)(lds + L_K + buf * KT_BYTES + (row * KS + 64 + ch * 8) * 2) = r.k[1];
    *(LAS v4u*)(lds + L_V + buf * VT_BYTES + (row * VS + ch * 8) * 2) = r.v[0]; *(LAS v4u*)(lds + L_V + buf * VT_BYTES + (row * VS + 64 + ch * 8) * 2) = r.v[1];
}
__device__ __forceinline__ void unit(Frame& F, int b, int hx, int qblk) {
    LAS unsigned char* lds = F.lds;
    const int tid = F.tid, lane = F.lane, w = F.wave, r32 = lane & 31, hi = lane >> 5;
    const size_t row = (size_t)b * T + qblk * 256 + w * 32 + r32;
    const bf16* QX = (const bf16*)(F.ws + WS_QX); const bf16* KVM = (const bf16*)(F.ws + WS_KVM) + (size_t)b * NMEM * 1024 + hx * 128; bf16* OX = (bf16*)(F.ws + WS_OX);
    bf16x8 qf[8];
#pragma unroll
    for (int ks = 0; ks < 8; ++ks) qf[ks] = *(const bf16x8*)(QX + row * 512 + hx * 128 + 16 * ks + 8 * hi);
    float m = nsa::NEG, l = 0.f; f32x16 o[4];
#pragma unroll
    for (int db = 0; db < 4; ++db)
#pragma unroll
        for (int r = 0; r < 16; ++r) o[db][r] = 0.f;
    { const TileRegs tr = load_tile(KVM, KVM + 512, tid); store_tile(lds, 0, tr, tid); }
    __syncthreads();
    int buf = 0;
#pragma unroll 1
    for (int j = 0; j < 4; ++j) {
        const bool has_next = j < 3; TileRegs tr;
        if (has_next) tr = load_tile(KVM + (size_t)(64 * (j + 1)) * 1024, KVM + (size_t)(64 * (j + 1)) * 1024 + 512, tid);
        f32x16 p0, p1;
#pragma unroll
        for (int r = 0; r < 16; ++r) { p0[r] = 0.f; p1[r] = 0.f; }
        const LAS unsigned char* Kt = lds + L_K + buf * KT_BYTES;
#pragma unroll
        for (int ks = 0; ks < 8; ++ks) {
            const bf16x8 a0 = *(const LAS bf16x8*)(Kt + (r32 * KS + 16 * ks + 8 * hi) * 2);
            const bf16x8 a1 = *(const LAS bf16x8*)(Kt + ((32 + r32) * KS + 16 * ks + 8 * hi) * 2);
            p0 = __builtin_amdgcn_mfma_f32_32x32x16_bf16(a0, qf[ks], p0, 0, 0, 0);
            p1 = __builtin_amdgcn_mfma_f32_32x32x16_bf16(a1, qf[ks], p1, 0, 0, 0);
        }
        float a = fmaxf(p0[0], p1[0]);
#pragma unroll
        for (int r = 1; r < 16; ++r) a = fmaxf(a, fmaxf(p0[r], p1[r]));
        a = nsa::xhalf_max(a);
        const float mn = fmaxf(m, a), alpha = __builtin_amdgcn_exp2f(m - mn);
        float s = 0.f;
#pragma unroll
        for (int r = 0; r < 16; ++r) { p0[r] = __builtin_amdgcn_exp2f(p0[r] - mn); p1[r] = __builtin_amdgcn_exp2f(p1[r] - mn); s += p0[r] + p1[r]; }
        s = nsa::xhalf_sum(s);
        l = l * alpha + s; m = mn;
#pragma unroll
        for (int db = 0; db < 4; ++db)
#pragma unroll
            for (int r = 0; r < 16; ++r) o[db][r] *= alpha;
        nsa::pv_tile<4>(o, lds + L_V + buf * VT_BYTES, VS, p0, p1, lane);
        if (has_next) store_tile(lds, buf ^ 1, tr, tid);
        __syncthreads();
        buf ^= 1;
    }
    const float inv = 1.0f / l;
#pragma unroll
    for (int db = 0; db < 4; ++db)
#pragma unroll
        for (int i = 0; i < 4; ++i) { v2u wv; wv.x = pk2(o[db][4 * i] * inv, o[db][4 * i + 1] * inv); wv.y = pk2(o[db][4 * i + 2] * inv, o[db][4 * i + 3] * inv);
            *(v2u*)(OX + row * 512 + hx * 128 + 32 * db + 8 * i + 4 * hi) = wv; }
}
__device__ __forceinline__ void phase(Frame& F) {
    for (int u = F.vcu; u < NB * 4 * 8; u += F.G) { unit(F, u >> 5, (u >> 3) & 3, u & 7); __syncthreads(); }
}
}

#ifndef MK_PER_PHASE_LAUNCH
#define MK_PER_PHASE_LAUNCH 0
#endif
constexpr int N_PHASES = 13;
struct Args { const float* in[24]; float* out; unsigned char* ws; int ph_lo, ph_hi; };

__global__ void __launch_bounds__(NTHREADS, 2) mk_fwd(Args args) {
    extern __shared__ __attribute__((aligned(16))) unsigned char lds_raw[];
    Frame F;
    F.lds = (LAS unsigned char*)lds_raw;
    F.tid = threadIdx.x; F.lane = F.tid & 63; F.wave = __builtin_amdgcn_readfirstlane(F.tid >> 6);
    F.G = gridDim.x; { const int bx = blockIdx.x; F.vcu = (F.G % 8 == 0) ? (bx % 8) * (F.G / 8) + bx / 8 : bx; }
    F.ws = args.ws; F.dout = (unsigned char*)args.out;
    volatile LAS unsigned* MISC = (volatile LAS unsigned*)(F.lds + MISC_OFF);
    for (int u = F.tid; u < (LDS_BYTES - RING_BYTES) / 4; u += NTHREADS) ((LAS unsigned*)(F.lds + RING_BYTES))[u] = 0u;
    __syncthreads();
    unsigned* ctl = (unsigned*)(F.ws + WS_CTL);
    XcdBarrier bar; bar.bar = ctl + CW_BAR; bar.x = 0; bar.st = nullptr;
    if (!MK_PER_PHASE_LAUNCH) bar = xcd_barrier_post(ctl + CW_BAR, MISC + 8);
    const int lo = args.ph_lo, hi = args.ph_hi;
#define IN(k) (lo <= (k) && (k) < hi)
#define SEAM(k) do { if (IN(k) && IN((k) + 1)) xcd_barrier(bar); } while (0)
    unsigned char* ws = F.ws;
    const float* x = args.in[0];
    float* hbuf = args.out;
    float* ss1 = (float*)(ws + CTL_SS1); float* ss2 = (float*)(ws + CTL_SS2); float* ss3 = (float*)(ws + CTL_SS3);
    const int gw = F.vcu * NWAVES + F.wave, NGW = F.G * NWAVES;

    if (IN(0)) {
        int cur = 0;
        const float* w_in = args.in[3];
        bf16* WIN = (bf16*)(ws + WS_WIN);
        transpose_job(F, w_in, INW, 1024, 0, 3072, WIN, 0, 0, cur);
        transpose_job(F, w_in, INW, 1024, 3072, 1024, WIN, 7936, 0, cur);
        transpose_job(F, w_in, INW, 1024, 4096, 2560, WIN, 3072, 0, cur);
        transpose_job(F, w_in, INW, 1024, 6656, 48, WIN, 7680, 0, cur);
        transpose_job(F, w_in, INW, 1024, 6704, 2048, WIN, 5632, 0, cur);
        transpose_job(F, args.in[12], 1024, 1024, 0, 1024, (bf16*)(ws + WS_WPR), 0, 0, cur);
        transpose_job(F, args.in[13], 1024, 1024, 0, 1024, (bf16*)(ws + WS_WPA), 0, 0, cur);
        transpose_job(F, args.in[14], 1024, 1024, 0, 1024, (bf16*)(ws + WS_WOUT), 0, 0, cur);
        transpose_job(F, args.in[17], 512, 1024, 0, 512, (bf16*)(ws + WS_WXQ), 0, 0, cur);
        transpose_job(F, args.in[18], 1024, 1024, 0, 1024, (bf16*)(ws + WS_WXKV), 0, 0, cur);
        transpose_job(F, args.in[19], 1024, 512, 0, 1024, (bf16*)(ws + WS_WXO), 0, 0, cur);
        __syncthreads();
        for (int m = gw; m < M; m += NGW) rms_row_to_bf16(x + (size_t)m * 1024, args.in[2], (bf16*)(ws + WS_A) + (size_t)m * 1024, F.lane);
        for (int m = gw; m < NB * NMEM; m += NGW) rms_row_to_bf16(args.in[1] + (size_t)m * 1024, args.in[16], (bf16*)(ws + WS_MEMN) + (size_t)m * 1024, F.lane);
        if (blockIdx.x == 0) { const float* lbr = args.in[4]; float* lb = (float*)(ws + WS_LB);
            for (int c = F.tid; c < 1024; c += NTHREADS) lb[c] = 1.0f / (1.0f + __expf(lbr[1024 + c] - lbr[c])); }
    }
    SEAM(0);
    if (IN(1)) {
        { pg8::Gemm g{(const pg8::bf16_t*)(ws + WS_A), (const pg8::bf16_t*)(ws + WS_WIN), M, 31 * 256, 1024}; pg8::StaticOrder S; S.init(M, 31 * 256, F.G, (int)blockIdx.x);
          epi::EpiInProj E{ws, F.dout, 0};
          pg8::gemm_phase<epi::EpiInProj, pg8::StaticOrder, true, true>(F.lds, g, S, E); }
        { pg8::Gemm g{(const pg8::bf16_t*)(ws + WS_MEMN), (const pg8::bf16_t*)(ws + WS_WXKV), NB * NMEM, 1024, 1024}; pg8::StaticOrder S; S.init(NB * NMEM, 1024, F.G, (int)blockIdx.x);
          epi::EpiStore E{(unsigned short*)(ws + WS_KVM), 1024};
          pg8::gemm_phase<epi::EpiStore, pg8::StaticOrder, true, true>(F.lds, g, S, E); }
    }
    SEAM(1);
    if (IN(2)) {
        if (F.vcu < 64) hgrn_naive(F, args.in[5]);
        else { Frame F2 = F; F2.vcu = F.vcu - 64; F2.G = F.G - 64; compress_naive(F2, args.in[6], args.in[7], args.in[8], args.in[9], args.in[10], args.in[11]); }
    }
    SEAM(2);
    if (IN(3)) {
        nsa::phase(F);
        { pg8::Gemm g{(const pg8::bf16_t*)(ws + WS_A), (const pg8::bf16_t*)(ws + WS_WIN) + (size_t)31 * 256 * 1024, M, 1024, 1024}; pg8::StaticOrder S; S.init(M, 1024, F.G, (int)blockIdx.x);
          epi::EpiInProj E{ws, F.dout, 31};
          pg8::gemm_phase<epi::EpiInProj, pg8::StaticOrder, true, true>(F.lds, g, S, E); }
    }
    SEAM(3);
    if (IN(4)) {
        { pg8::Gemm g{(const pg8::bf16_t*)(ws + WS_QATT), (const pg8::bf16_t*)(ws + WS_WPA), M, 1024, 1024}; pg8::StaticOrder S; S.init(M, 1024, F.G, (int)blockIdx.x);
          epi::EpiGateMul E{(const unsigned short*)(F.dout + 32 * MiB), (unsigned short*)(ws + WS_MERGED), 0};
          pg8::gemm_phase<epi::EpiGateMul, pg8::StaticOrder, true, true>(F.lds, g, S, E); }
        { pg8::Gemm g{(const pg8::bf16_t*)(ws + WS_QA), (const pg8::bf16_t*)(ws + WS_WPR), M, 1024, 1024}; pg8::StaticOrder S; S.init(M, 1024, F.G, (int)blockIdx.x);
          epi::EpiGateMul E{(const unsigned short*)(F.dout), (unsigned short*)(ws + WS_MERGED), 1};
          pg8::gemm_phase<epi::EpiGateMul, pg8::StaticOrder, true, true>(F.lds, g, S, E); }
    }
    SEAM(4);
    if (IN(5)) {
        { pg8::Gemm g{(const pg8::bf16_t*)(ws + WS_MERGED), (const pg8::bf16_t*)(ws + WS_WOUT), M, 1024, 1024}; pg8::StaticOrder S; S.init(M, 1024, F.G, (int)blockIdx.x);
          epi::EpiResid E{x, hbuf, args.in[15], (unsigned short*)(ws + WS_A), ss1};
          pg8::gemm_phase<epi::EpiResid, pg8::StaticOrder, true, true>(F.lds, g, S, E); }
        int cur = 0;
        transpose_job(F, args.in[21], 2 * DFF, 1024, 0, DFF, (bf16*)(ws + WS_WGU), 0, 1, cur);
        transpose_job(F, args.in[21], 2 * DFF, 1024, DFF, DFF, (bf16*)(ws + WS_WGU), 128, 1, cur);
        transpose_job(F, args.in[22], 1024, DFF, 0, 1024, (bf16*)(ws + WS_WDN), 0, 0, cur);
    }
    SEAM(5);
    if (IN(6)) {
        pg8::Gemm g{(const pg8::bf16_t*)(ws + WS_A), (const pg8::bf16_t*)(ws + WS_WXQ), M, 512, 1024}; pg8::StaticOrder S; S.init(M, 512, F.G, (int)blockIdx.x);
        epi::EpiRowScale E{ss1, (unsigned short*)(ws + WS_QX), 512, XSCALE};
        pg8::gemm_phase<epi::EpiRowScale, pg8::StaticOrder, true, true>(F.lds, g, S, E);
    }
    SEAM(6);
    if (IN(7)) xat::phase(F);
    SEAM(7);
    if (IN(8)) {
        pg8::Gemm g{(const pg8::bf16_t*)(ws + WS_OX), (const pg8::bf16_t*)(ws + WS_WXO), M, 1024, 512}; pg8::StaticOrder S; S.init(M, 1024, F.G, (int)blockIdx.x);
        epi::EpiResid E{hbuf, hbuf, args.in[20], (unsigned short*)(ws + WS_QA), ss2};
        pg8::gemm_phase<epi::EpiResid, pg8::StaticOrder, true, true>(F.lds, g, S, E);
    }
    SEAM(8);
    if (IN(9)) {
        pg8::Gemm g{(const pg8::bf16_t*)(ws + WS_QA), (const pg8::bf16_t*)(ws + WS_WGU), M, 2 * DFF, 1024}; pg8::StaticOrder S; S.init(M, 2 * DFF, F.G, (int)blockIdx.x);
        epi::EpiSwiglu E{ss2, (unsigned short*)(ws + WS_ACT)};
        pg8::gemm_phase<epi::EpiSwiglu, pg8::StaticOrder, true, true>(F.lds, g, S, E);
    }
    SEAM(9);
    if (IN(10)) {
        pg8::Gemm g{(const pg8::bf16_t*)(ws + WS_ACT), (const pg8::bf16_t*)(ws + WS_WDN), M, 1024, DFF}; pg8::StaticOrder S; S.init(M, 1024, F.G, (int)blockIdx.x);
        epi::EpiResid E{hbuf, hbuf, nullptr, nullptr, ss3};
        pg8::gemm_phase<epi::EpiResid, pg8::StaticOrder, true, true>(F.lds, g, S, E);
    }
    SEAM(10);
    if (IN(11)) {
        const float* gf = args.in[23];
        for (int m = gw; m < M; m += NGW) {
            const float r = __builtin_amdgcn_rsqf(ss3[m] * (1.0f / 1024.0f) + EPS);
            GAS f32x4* hr = (GAS f32x4*)(hbuf + (size_t)m * 1024) + F.lane; const GAS f32x4* gr = (const GAS f32x4*)gf + F.lane;
#pragma unroll
            for (int j = 0; j < 4; ++j) { const f32x4 v = hr[64 * j], gg = gr[64 * j]; hr[64 * j] = v * r * gg; }
        }
    }
#undef IN
#undef SEAM
}

extern "C" void kernel_launch(void* const* d_in, const int* in_sizes, int n_in, void* d_out, int out_size, void* d_ws, size_t ws_size, hipStream_t stream) {
    static int grid = 0;
    if (grid == 0) {
        if (n_in != 24 || out_size != M * D || ws_size < WS_END) { fprintf(stderr, "kernel_launch: unexpected shapes (n_in %d out %d ws %zu)\n", n_in, out_size, ws_size); grid = -1; return; }
        int dev = 0, cus = 0, per_cu = 0;
        if (hipGetDevice(&dev) != hipSuccess || hipDeviceGetAttribute(&cus, hipDeviceAttributeMultiprocessorCount, dev) != hipSuccess) { grid = -1; return; }
        if (hipFuncSetAttribute((const void*)mk_fwd, hipFuncAttributeMaxDynamicSharedMemorySize, LDS_BYTES) != hipSuccess) { fprintf(stderr, "kernel_launch: hipFuncSetAttribute failed\n"); grid = -1; return; }
        if (hipOccupancyMaxActiveBlocksPerMultiprocessor(&per_cu, (const void*)mk_fwd, NTHREADS, LDS_BYTES) != hipSuccess || per_cu < 1) { fprintf(stderr, "kernel_launch: occupancy query says %d blocks per CU\n", per_cu); grid = -1; (void)hipGetLastError(); return; }
        (void)hipGetLastError();
        grid = cus;
    }
    if (grid < 0) return;
    if (hipMemsetAsync((char*)d_ws + WS_CTL, 0, CTL_ZERO_BYTES, stream) != hipSuccess) return;
    Args a{};
    for (int i = 0; i < 24; ++i) a.in[i] = (const float*)d_in[i];
    a.out = (float*)d_out; a.ws = (unsigned char*)d_ws;
#if MK_PER_PHASE_LAUNCH
    for (int p = 0; p < N_PHASES; ++p) { a.ph_lo = p; a.ph_hi = p + 1; hipLaunchKernelGGL(mk_fwd, dim3(grid), dim3(NTHREADS), LDS_BYTES, stream, a); }
#else
    a.ph_lo = 0; a.ph_hi = N_PHASES;
    hipLaunchKernelGGL(mk_fwd, dim3(grid), dim3(NTHREADS), LDS_BYTES, stream, a);
#endif
}
```

```cpp
#include <hip/hip_runtime.h>
#include <cstdio>
#include <cstdint>
namespace pg8 {
#define PG8_LAS __attribute__((address_space(3)))
typedef unsigned short bf16_t;
typedef short bf16x8 __attribute__((ext_vector_type(8)));
typedef float f32x4 __attribute__((ext_vector_type(4)));
typedef unsigned u32x4 __attribute__((ext_vector_type(4)));
constexpr int BM = 256, BK = 64, HALF = 128, HTB = HALF * BK * 2  , STAGE_BYTES = 8 * HTB, NXCD = 8, WGM = 8;

__host__ __device__ __forceinline__ int lds_byte(int r, int c) { const int st = (r >> 4) * 2 + (c >> 5), rr = r & 15, cc = c & 31, ob = rr * 64 + cc * 2; return st * 1024 + (ob ^ (((ob >> 9) & 1) << 5)); }
__host__ __device__ __forceinline__ void stage_rc(int b, int& R, int& C) { const int st = b / 1024, sb = b % 1024, swz = sb ^ (((sb >> 9) & 1) << 5); R = (st >> 1) * 16 + swz / 64; C = (st & 1) * 32 + (swz % 64) / 2; }
__host__ __device__ __forceinline__ int perm32(int rho) { const int n = rho >> 4, i = rho & 15; return 8 * (i >> 2) + 4 * n + (i & 3); }

struct Unit { int pm, pn; };
struct Gemm { const bf16_t* A; const bf16_t* Bt; int M, N, K; };

struct StaticOrder {
    int nM, nN, nwg, G, c;
    __host__ __device__ void init(int M, int N, int G_, int c_) { nM = M / BM; nN = N / BM; nwg = nM * nN; G = G_; c = c_; }
    __host__ __device__ bool next(int i, Unit& u) const {
        const long L = (long)i * G + c; if (L >= nwg) return false;
        int wgid = (int)L; { const int q = nwg / NXCD, r = nwg % NXCD, xcd = wgid % NXCD, off = wgid / NXCD; wgid = (xcd < r ? xcd * (q + 1) : r * (q + 1) + (xcd - r) * q) + off; }
        const int nig = WGM * nN, gid = wgid / nig, fm = gid * WGM, gsz = (nM - fm) < WGM ? (nM - fm) : WGM;
        u.pm = fm + ((wgid % nig) % gsz); u.pn = (wgid % nig) / gsz; return true;
    }
    __device__ __forceinline__ void a_ready(const Unit&) const {}
    __device__ __forceinline__ void done(const Unit&) const {}
};

__device__ __forceinline__ unsigned cvt_pk_bf16(float lo, float hi) { unsigned r; asm volatile("v_cvt_pk_bf16_f32 %0, %1, %2" : "=v"(r) : "v"(lo), "v"(hi)); return r; }
typedef float f32x2 __attribute__((ext_vector_type(2)));
__device__ __forceinline__ f32x2 gelu_pk(f32x2 v) {
    const f32x2 av = __builtin_elementwise_abs(v), d = av * 0.2316418882f + 1.0f;
    f32x2 t; t.x = __builtin_amdgcn_rcpf(d.x); t.y = __builtin_amdgcn_rcpf(d.y);
    f32x2 q = t * 0.5307027145f + (-0.7265760135f); q = q * t + 0.7107068705f; q = q * t + (-0.142248368f); q = q * t + 0.127414796f; q = q * t;
    const f32x2 s = (v * v) * (-0.72134752044f);
    f32x2 e; e.x = __builtin_amdgcn_exp2f(s.x); e.y = __builtin_amdgcn_exp2f(s.y);
    const f32x2 m = v * (q * e), r = v - m;
    f32x2 o; o.x = v.x < 0.f ? m.x : r.x; o.y = v.y < 0.f ? m.y : r.y; return o;
}

template <int ACT  > struct EpiBf16 {
    static constexpr bool PERM = true, AFTER_DRAIN = false; static_assert(ACT == 0 || ACT == 1, "EpiBf16: ACT is 0 (none) or 1 (gelu_pk)");
    bf16_t* O; int ldc; const float* bias; int split_cols; size_t split_stride; float scale0;
    __device__ __forceinline__ void operator()(const f32x4 (&acc)[2][2][4][2], const Unit& u, int wr, int wc, int fr, int fq) const {
        const int row0 = u.pm * BM + wr * 64 + fr; int colt = u.pn * BM; bf16_t* base = O;
        float sc = 1.f; if (split_cols) { const int t = colt / split_cols; base += (size_t)t * split_stride; colt -= t * split_cols; if (t == 0) sc = scale0; }
        const int col0 = colt + wc * 32 + 8 * fq, bcol0 = u.pn * BM + wc * 32 + 8 * fq;
        f32x4 bv[2][2];
#pragma unroll
        for (int bj = 0; bj < 2; ++bj)
#pragma unroll
            for (int n = 0; n < 2; ++n) bv[bj][n] = bias ? *(const f32x4*)(bias + bcol0 + bj * HALF + 4 * n) : (f32x4){0.f, 0.f, 0.f, 0.f};
#pragma unroll
        for (int ai = 0; ai < 2; ++ai)
#pragma unroll
            for (int m = 0; m < 4; ++m) { bf16_t* rowp = base + (size_t)(row0 + ai * HALF + m * 16) * ldc + col0;
#pragma unroll
                for (int bj = 0; bj < 2; ++bj) { f32x4 v0 = acc[ai][bj][m][0] + bv[bj][0], v1 = acc[ai][bj][m][1] + bv[bj][1];
                    if (ACT == 1) { f32x2 a = gelu_pk((f32x2){v0[0], v0[1]}), b = gelu_pk((f32x2){v0[2], v0[3]}), c = gelu_pk((f32x2){v1[0], v1[1]}), d = gelu_pk((f32x2){v1[2], v1[3]});
                        v0 = (f32x4){a.x, a.y, b.x, b.y}; v1 = (f32x4){c.x, c.y, d.x, d.y}; }
                    v0 = v0 * sc; v1 = v1 * sc; u32x4 w; w.x = cvt_pk_bf16(v0[0], v0[1]); w.y = cvt_pk_bf16(v0[2], v0[3]); w.z = cvt_pk_bf16(v1[0], v1[1]); w.w = cvt_pk_bf16(v1[2], v1[3]);
                    *(u32x4*)(rowp + bj * HALF) = w; } }
    }
};
template <class Epi, class Sched, bool ALIGN_EPI = false, bool SP2 = false>
__device__ __forceinline__ void gemm_phase(PG8_LAS unsigned char* lds, const Gemm g, const Sched& S, const Epi& E) {
    const int tid = threadIdx.x, wid = __builtin_amdgcn_readfirstlane(tid >> 6), lane = tid & 63, wr = wid >> 2, wc = wid & 3, fr = lane & 15, fq = lane >> 4;
    const int K = g.K, nt = K / BK;
    unsigned voffA[2], voffB[2];
#pragma unroll
    for (int i = 0; i < 2; ++i) { int R, C; stage_rc(tid * 16 + i * 8192, R, C); const int Rb = Epi::PERM ? ((R & ~31) + perm32(R & 31)) : R;
        voffA[i] = (unsigned)(R * K + C) * 2u; voffB[i] = (unsigned)(Rb * K + C) * 2u; }
    const size_t kstep = (size_t)(BK * 2);
    const size_t hstep = (size_t)HALF * K * 2;
    const size_t tstep = 2 * hstep;
    const unsigned ldsw = (unsigned)wid * 1024u;
    const int aoff = lds_byte(wr * 64 + fr, fq * 8), boff = lds_byte(wc * 32 + fr, fq * 8);
#define PG8_SA(b, h) (((b) * 2 + (h)) * HTB)
#define PG8_SB(b, h) ((4 + (b) * 2 + (h)) * HTB)
#define PG8_STAGE(bufoff, gbase, voff) do { _Pragma("unroll") for (int _i = 0; _i < 2; ++_i) \
        __builtin_amdgcn_global_load_lds((const unsigned*)((const char*)(gbase) + (voff)[_i]), (PG8_LAS unsigned*)(lds + (bufoff) + ldsw + _i * 8192), 16, 0, 0); } while (0)
#define PG8_LDA(dst, b, h) do { _Pragma("unroll") for (int m = 0; m < 4; ++m) _Pragma("unroll") for (int k = 0; k < 2; ++k) dst[m][k] = *(const PG8_LAS bf16x8*)(lds + PG8_SA(b, h) + aoff + m * 2048 + k * 1024); } while (0)
#define PG8_LDB(dst, b, h) do { _Pragma("unroll") for (int n = 0; n < 2; ++n) _Pragma("unroll") for (int k = 0; k < 2; ++k) dst[n][k] = *(const PG8_LAS bf16x8*)(lds + PG8_SB(b, h) + boff + n * 2048 + k * 1024); } while (0)
#define PG8_MMA(ai, bj, At, Bt) do { __builtin_amdgcn_s_setprio(1); _Pragma("unroll") for (int m = 0; m < 4; ++m) _Pragma("unroll") for (int n = 0; n < 2; ++n) _Pragma("unroll") for (int k = 0; k < 2; ++k) \
        acc[ai][bj][m][n] = __builtin_amdgcn_mfma_f32_16x16x32_bf16(Bt[n][k], At[m][k], acc[ai][bj][m][n], 0, 0, 0); __builtin_amdgcn_s_setprio(0); } while (0)
#define PG8_WAIT_V(n) asm volatile("s_waitcnt vmcnt(" #n ")" ::: "memory")
#define PG8_WAIT_L(n) asm volatile("s_waitcnt lgkmcnt(" #n ")" ::: "memory")
#define PG8_BAR __builtin_amdgcn_s_barrier()
#define PG8_SCHED __builtin_amdgcn_sched_barrier(0)
    Unit cur, nxt; int ui = 0;
    if (!S.next(0, cur)) return;
    f32x4 acc[2][2][4][2];
#pragma unroll
    for (int a = 0; a < 2; ++a)
#pragma unroll
        for (int b = 0; b < 2; ++b)
#pragma unroll
            for (int m = 0; m < 4; ++m)
#pragma unroll
                for (int n = 0; n < 2; ++n) acc[a][b][m][n] = (f32x4){0.f, 0.f, 0.f, 0.f};
    bf16x8 At[4][2], B0[2][2], B1[2][2];
    const char* cA = (const char*)g.A + (size_t)cur.pm * tstep; const char* cB = (const char*)g.Bt + (size_t)cur.pn * tstep;
    S.a_ready(cur);
    if constexpr (SP2) {
        PG8_STAGE(PG8_SB(0, 0), cB, voffB); PG8_STAGE(PG8_SB(0, 1), cB + hstep, voffB); PG8_STAGE(PG8_SA(0, 0), cA, voffA); PG8_STAGE(PG8_SA(0, 1), cA + hstep, voffA);
        if (wr == 1) PG8_BAR;
        PG8_WAIT_V(2); PG8_BAR;
        PG8_STAGE(PG8_SB(1, 0), cB + kstep, voffB); PG8_STAGE(PG8_SA(1, 0), cA + kstep, voffA); PG8_STAGE(PG8_SB(1, 1), cB + hstep + kstep, voffB);
        PG8_WAIT_V(6); PG8_BAR;
    } else {
        PG8_STAGE(PG8_SB(0, 0), cB, voffB); PG8_STAGE(PG8_SA(0, 0), cA, voffA); PG8_STAGE(PG8_SB(0, 1), cB + hstep, voffB); PG8_STAGE(PG8_SA(0, 1), cA + hstep, voffA);
        if (wr == 1) PG8_BAR;
        PG8_WAIT_V(4); PG8_BAR;
        PG8_STAGE(PG8_SB(1, 0), cB + kstep, voffB); PG8_STAGE(PG8_SA(1, 0), cA + kstep, voffA); PG8_STAGE(PG8_SB(1, 1), cB + hstep + kstep, voffB);
        PG8_WAIT_V(6); PG8_BAR;
    }
    for (;;) {
        const bool has_next = S.next(ui + 1, nxt);
        const char* nA = has_next ? (const char*)g.A + (size_t)nxt.pm * tstep : cA; const char* nB = has_next ? (const char*)g.Bt + (size_t)nxt.pn * tstep : cB;
        for (int t = 0; t < nt; t += 2) {
            const bool last = (t == nt - 2);
            const char* a1 = cA + (size_t)(t + 1) * kstep;
            const char* a2 = last ? nA : cA + (size_t)(t + 2) * kstep; const char* b2 = last ? nB : cB + (size_t)(t + 2) * kstep;
            const char* a3 = a2 + kstep; const char* b3 = b2 + kstep;
            if (last && has_next) S.a_ready(nxt);
            if constexpr (SP2) {
            PG8_LDB(B0, 0, 0); PG8_LDB(B1, 0, 1); PG8_SCHED; PG8_LDA(At, 0, 0); PG8_STAGE(PG8_SA(1, 1), a1 + hstep, voffA);
            PG8_WAIT_V(8); PG8_WAIT_L(0); PG8_BAR; PG8_MMA(0, 0, At, B0); PG8_MMA(0, 1, At, B1); PG8_BAR; PG8_SCHED;
            PG8_LDA(At, 0, 1); PG8_STAGE(PG8_SB(0, 0), b2, voffB); PG8_STAGE(PG8_SB(0, 1), b2 + hstep, voffB); PG8_STAGE(PG8_SA(0, 0), a2, voffA);
            PG8_WAIT_V(8); PG8_WAIT_L(0); PG8_BAR; PG8_MMA(1, 0, At, B0); PG8_MMA(1, 1, At, B1); PG8_BAR; PG8_SCHED;
            PG8_LDB(B0, 1, 0); PG8_LDB(B1, 1, 1); PG8_SCHED; PG8_LDA(At, 1, 0); PG8_STAGE(PG8_SA(0, 1), a2 + hstep, voffA);
            PG8_WAIT_V(8); PG8_WAIT_L(0); PG8_BAR; PG8_MMA(0, 0, At, B0); PG8_MMA(0, 1, At, B1); PG8_BAR; PG8_SCHED;
            PG8_LDA(At, 1, 1); PG8_STAGE(PG8_SB(1, 0), b3, voffB); PG8_STAGE(PG8_SB(1, 1), b3 + hstep, voffB); PG8_STAGE(PG8_SA(1, 0), a3, voffA);
            PG8_WAIT_V(8); PG8_WAIT_L(0); PG8_BAR; PG8_MMA(1, 0, At, B0); PG8_MMA(1, 1, At, B1); PG8_BAR; PG8_SCHED;
            } else {
            PG8_LDB(B0, 0, 0); PG8_SCHED; PG8_LDA(At, 0, 0); PG8_STAGE(PG8_SA(1, 1), a1 + hstep, voffA);
            PG8_WAIT_L(8); PG8_BAR; PG8_WAIT_L(0); PG8_MMA(0, 0, At, B0); PG8_BAR; PG8_SCHED;
            PG8_LDB(B1, 0, 1); PG8_STAGE(PG8_SB(0, 0), b2, voffB);
            PG8_BAR; PG8_WAIT_L(0); PG8_MMA(0, 1, At, B1); PG8_BAR;
            PG8_LDA(At, 0, 1); PG8_STAGE(PG8_SA(0, 0), a2, voffA);
            PG8_BAR; PG8_WAIT_L(0); PG8_MMA(1, 0, At, B0); PG8_BAR; PG8_SCHED;
            PG8_STAGE(PG8_SB(0, 1), b2 + hstep, voffB);
            PG8_WAIT_V(6); PG8_BAR; PG8_MMA(1, 1, At, B1); PG8_BAR;
            PG8_LDB(B0, 1, 0); PG8_SCHED; PG8_LDA(At, 1, 0); PG8_STAGE(PG8_SA(0, 1), a2 + hstep, voffA);
            PG8_WAIT_L(8); PG8_BAR; PG8_WAIT_L(0); PG8_MMA(0, 0, At, B0); PG8_BAR; PG8_SCHED;
            PG8_LDB(B1, 1, 1); PG8_STAGE(PG8_SB(1, 0), b3, voffB);
            PG8_BAR; PG8_WAIT_L(0); PG8_MMA(0, 1, At, B1); PG8_BAR;
            PG8_LDA(At, 1, 1); PG8_STAGE(PG8_SA(1, 0), a3, voffA);
            PG8_BAR; PG8_WAIT_L(0); PG8_MMA(1, 0, At, B0); PG8_BAR; PG8_SCHED;
            PG8_STAGE(PG8_SB(1, 1), b3 + hstep, voffB);
            PG8_WAIT_V(6); PG8_BAR; PG8_MMA(1, 1, At, B1); PG8_BAR;
            }
        }
        if constexpr (ALIGN_EPI) { if (wr == 0) PG8_BAR; }
        if constexpr (!Epi::AFTER_DRAIN) { E(acc, cur, wr, wc, fr, fq); S.done(cur); }
        if (!has_next) break;
#pragma unroll
        for (int a = 0; a < 2; ++a)
#pragma unroll
            for (int b = 0; b < 2; ++b)
#pragma unroll
                for (int m = 0; m < 4; ++m)
#pragma unroll
                    for (int n = 0; n < 2; ++n) acc[a][b][m][n] = (f32x4){0.f, 0.f, 0.f, 0.f};
        cur = nxt; cA = nA; cB = nB; ++ui;
        if constexpr (ALIGN_EPI) { if (wr == 1) PG8_BAR; }
    }
    PG8_WAIT_V(0);
    if constexpr (!ALIGN_EPI) { if (wr == 0) PG8_BAR; }
    PG8_BAR;
    if constexpr (Epi::AFTER_DRAIN) { E.fused(acc, cur, wr, wc, fr, fq, lds, wid, lane); S.done(cur); }
#undef PG8_SA
#undef PG8_SB
#undef PG8_STAGE
#undef PG8_LDA
#undef PG8_LDB
#undef PG8_MMA
#undef PG8_WAIT_V
#undef PG8_WAIT_L
#undef PG8_BAR
#undef PG8_SCHED
}
}

#define GAS __attribute__((address_space(1)))
#define LAS __attribute__((address_space(3)))
typedef unsigned short bf16;
typedef unsigned v4u __attribute__((ext_vector_type(4)));
typedef unsigned v2u __attribute__((ext_vector_type(2)));
typedef float f32x4 __attribute__((ext_vector_type(4)));
typedef float f32x16 __attribute__((ext_vector_type(16)));
typedef short bf16x8 __attribute__((ext_vector_type(8)));
typedef short s16x4 __attribute__((ext_vector_type(4)));
typedef _Float16 half_t;

constexpr int NWAVES = 8, NTHREADS = 512;
constexpr int M = 16384, D = 1024, T = 2048, NB = 8, NMEM = 256, DFF = 2816, INW = 8752;
constexpr float EPS = 1e-6f;
constexpr float LOG2E = 1.4426950408889634f;
constexpr float QSCALE = 0.125f * LOG2E;
constexpr float XSCALE = 0.08838834764831845f * LOG2E;

constexpr size_t MiB = 1u << 20;
constexpr size_t WS_CTL = 0, CTL_ZERO_BYTES = 1 * MiB;
constexpr size_t CTL_SS1 = 256 * 1024, CTL_SS2 = 320 * 1024, CTL_SS3 = 384 * 1024;
constexpr int CW_BAR = 4096;
constexpr size_t WS_LB = 1 * MiB;
constexpr size_t WS_WIN = 2 * MiB;
constexpr size_t WS_WPR = 20 * MiB, WS_WPA = 22 * MiB, WS_WOUT = 24 * MiB, WS_WXQ = 26 * MiB, WS_WXKV = 27 * MiB, WS_WXO = 29 * MiB;
constexpr size_t WS_WC1K = 30 * MiB, WS_WC1V = 30 * MiB + 512 * 1024;
constexpr size_t WS_KC = 31 * MiB, WS_VC = 31 * MiB + 512 * 1024;
constexpr size_t WS_KVM = 32 * MiB;
constexpr size_t WS_GATES = 36 * MiB;
constexpr size_t WS_MEMN = 38 * MiB;
constexpr size_t WS_A = 42 * MiB;
constexpr size_t WS_QA = 74 * MiB;
constexpr size_t WS_LOGF = 106 * MiB;
constexpr size_t WS_WGU = 106 * MiB, WS_WDN = 117 * MiB;
constexpr size_t WS_I = 138 * MiB;
constexpr size_t WS_MERGED = 138 * MiB, WS_QX = 138 * MiB, WS_OX = 154 * MiB;
constexpr size_t WS_QATT = 170 * MiB;
constexpr size_t WS_KV = 202 * MiB;
constexpr size_t WS_ACT = 138 * MiB;
constexpr size_t WS_END = 250 * MiB;
static_assert(WS_ACT + (size_t)M * DFF * 2 <= WS_END && WS_WDN + (size_t)1024 * DFF * 2 <= WS_I, "ws map");

constexpr int RING_BYTES = 131072;
constexpr int MISC_OFF = RING_BYTES + 320;
constexpr int LDS_BYTES = 147456;

#define RLX_AGENT __ATOMIC_RELAXED, __HIP_MEMORY_SCOPE_AGENT
__device__ __forceinline__ unsigned f2bf(float f) { unsigned u = __builtin_bit_cast(unsigned, f); return (u + 0x7fffu + ((u >> 16) & 1u)) >> 16; }
__device__ __forceinline__ unsigned pk2(float lo, float hi) { return f2bf(lo) | (f2bf(hi) << 16); }
__device__ __forceinline__ float bf2f(unsigned short b) { return __builtin_bit_cast(float, (unsigned)b << 16); }
__device__ __forceinline__ float bflo(unsigned w) { return __builtin_bit_cast(float, w << 16); }
__device__ __forceinline__ float bfhi(unsigned w) { return __builtin_bit_cast(float, w & 0xffff0000u); }
__device__ __forceinline__ float fast_exp(float x) { return __builtin_amdgcn_exp2f(x * LOG2E); }
__device__ __forceinline__ float fast_rcp(float x) { return __builtin_amdgcn_rcpf(x); }
__device__ __forceinline__ float sigm(float x) { return fast_rcp(1.0f + fast_exp(-x)); }
__device__ __forceinline__ float silu(float x) { return x * sigm(x); }
__device__ __forceinline__ float wave_sum(float v) {
#pragma unroll
    for (int o = 1; o < 64; o <<= 1) v += __shfl_xor(v, o);
    return v;
}
__device__ __forceinline__ float wave_max(float v) {
#pragma unroll
    for (int o = 1; o < 64; o <<= 1) v = fmaxf(v, __shfl_xor(v, o));
    return v;
}
#define XB_TMO      128
#define XB_XCNT(j)  (256  + 64 * (j))
#define XB_XSUB(j)  (1280 + 64 * (j))
#define XB_XGEN(j)  (2304 + 64 * (j))
#define XB_TOP      3328
#define XB_TOPGEN   3392
#define XCD_BAR_WORDS 3456
#define XB_SPIN_CAP (1u << 18)

__device__ __forceinline__ unsigned xb_ld(unsigned* p)              { return __hip_atomic_load(p, __ATOMIC_RELAXED, __HIP_MEMORY_SCOPE_AGENT); }
__device__ __forceinline__ unsigned xb_add(unsigned* p, unsigned v) { return __hip_atomic_fetch_add(p, v, __ATOMIC_RELAXED, __HIP_MEMORY_SCOPE_AGENT); }
__device__ __forceinline__ unsigned xb_xcc_id() { return (unsigned)__builtin_amdgcn_s_getreg((3 << 11) | 20) & 0xFu; }
#define XB_SPIN(cond, bar) do { unsigned _sp = 0; while (cond) { __builtin_amdgcn_s_sleep(1); \
    if ((++_sp & 255u) == 0u) { if (xb_ld(&(bar)[XB_TMO])) break; if (_sp > XB_SPIN_CAP) { atomicAdd(&(bar)[XB_TMO], 1u); break; } } } } while (0)

struct XcdBarrier {
    unsigned* bar; unsigned x;
    volatile LAS unsigned* st;
};

__device__ __forceinline__ XcdBarrier xcd_barrier_post(unsigned* bar, volatile LAS unsigned* st) {
    XcdBarrier b; b.bar = bar; b.x = xb_xcc_id(); b.st = st;
    if (threadIdx.x == 0) (void)xb_add(&bar[XB_XCNT(b.x)], 1u);
    return b;
}
__device__ __forceinline__ void xcd_barrier_complete(unsigned* bar, unsigned x, unsigned& nloc, unsigned& nx) {
    const unsigned G = gridDim.x * gridDim.y * gridDim.z;
    unsigned sum, cnt, mine, sp = 0u;
    for (;;) {
        sum = 0u; cnt = 0u; mine = 0u;
#pragma unroll
        for (unsigned j = 0; j < 16; ++j) { const unsigned c = xb_ld(&bar[XB_XCNT(j)]); sum += c; cnt += (c > 0u) ? 1u : 0u; mine = (j == x) ? c : mine; }
        if (sum == G) break;
        __builtin_amdgcn_s_sleep(1);
        if ((++sp & 255u) == 0u) { if (xb_ld(&bar[XB_TMO])) break; if (sp > XB_SPIN_CAP) { atomicAdd(&bar[XB_TMO], 1u); break; } }
    }
    nloc = mine > 0u ? mine : 1u; nx = cnt > 0u ? cnt : 1u;
}

__device__ __forceinline__ void xcd_barrier(const XcdBarrier& b) {
    asm volatile("s_waitcnt vmcnt(0)" ::: "memory");
    __syncthreads();
    if (threadIdx.x == 0) {
        unsigned* bar = b.bar;
        __builtin_amdgcn_s_waitcnt(0);
        unsigned nloc = b.st[0], nx = b.st[1];
        if (nloc == 0u) { xcd_barrier_complete(bar, b.x, nloc, nx); b.st[0] = nloc; b.st[1] = nx; }
        const unsigned old = xb_add(&bar[XB_XSUB(b.x)], 1u);
        const unsigned gen = old / nloc;
        if (old + 1u == (gen + 1u) * nloc) {
            __builtin_amdgcn_fence(__ATOMIC_RELEASE, "agent");
            asm volatile("s_waitcnt vmcnt(0)" ::: "memory");
            const unsigned og = xb_add(&bar[XB_TOP], 1u);
            const unsigned tg = og / nx;
            if (og + 1u == (tg + 1u) * nx) xb_add(&bar[XB_TOPGEN], 1u);
            else XB_SPIN(xb_ld(&bar[XB_TOPGEN]) == tg, bar);
            __builtin_amdgcn_fence(__ATOMIC_ACQUIRE, "agent");
            xb_add(&bar[XB_XGEN(b.x)], 1u);
            asm volatile("s_waitcnt vmcnt(0)" ::: "memory");
        } else {
            XB_SPIN(xb_ld(&bar[XB_XGEN(b.x)]) == gen, bar);
            __builtin_amdgcn_fence(__ATOMIC_ACQUIRE, "agent");
            asm volatile("s_waitcnt vmcnt(0)" ::: "memory");
        }
    }
    __syncthreads();
}

namespace epi {
using pg8::Unit; using pg8::HALF; using pg8::BM;
typedef pg8::f32x4 f4; typedef pg8::u32x4 u4;
__device__ __forceinline__ u4 pack8(f4 a, f4 b) { u4 w; w.x = pk2(a[0], a[1]); w.y = pk2(a[2], a[3]); w.z = pk2(b[0], b[1]); w.w = pk2(b[2], b[3]); return w; }
__device__ __forceinline__ void unpack8(u4 w, f4& a, f4& b) { a = (f4){bflo(w.x), bfhi(w.x), bflo(w.y), bfhi(w.y)}; b = (f4){bflo(w.z), bfhi(w.z), bflo(w.w), bfhi(w.w)}; }
__device__ __forceinline__ f4 map_sigm(f4 v) { return (f4){sigm(v[0]), sigm(v[1]), sigm(v[2]), sigm(v[3])}; }
__device__ __forceinline__ f4 map_silu(f4 v) { return (f4){silu(v[0]), silu(v[1]), silu(v[2]), silu(v[3])}; }

struct EpiInProj {
    static constexpr bool PERM = true, AFTER_DRAIN = false;
    unsigned char* ws; unsigned char* dout; int tile0;
    __device__ __forceinline__ void operator()(const f4 (&acc)[2][2][4][2], const Unit& u, int wr, int wc, int fr, int fq) const {
        const int ct = tile0 + u.pn;
        int kind, ldc, colt; unsigned short* base;
        if (ct < 4) { kind = 0; base = (unsigned short*)(ws + WS_QA); ldc = 1024; colt = ct * 256; }
        else if (ct < 8) { kind = 1; base = (unsigned short*)(ws + WS_LOGF); ldc = 1024; colt = (ct - 4) * 256; }
        else if (ct < 12) { kind = 2; base = (unsigned short*)(ws + WS_I); ldc = 1024; colt = (ct - 8) * 256; }
        else if (ct < 16) { kind = 3; base = (unsigned short*)(ws + WS_QATT); ldc = 1024; colt = (ct - 12) * 256; }
        else if (ct < 22) { kind = 2; base = (unsigned short*)(ws + WS_KV); ldc = 1536; colt = (ct - 16) * 256; }
        else if (ct < 26) { kind = 4; base = (unsigned short*)(dout); ldc = 1024; colt = (ct - 22) * 256; }
        else if (ct < 30) { kind = 4; base = (unsigned short*)(dout + 32 * MiB); ldc = 1024; colt = (ct - 26) * 256; }
        else if (ct == 30) { kind = 5; base = (unsigned short*)(ws + WS_GATES); ldc = 64; colt = 0; }
        else { kind = 6; base = (unsigned short*)(ws + WS_QA); ldc = 1024; colt = (ct - 31) * 256; }
        const int row0 = u.pm * BM + wr * 64 + fr;
        const int col0 = colt + wc * 32 + 8 * fq;
        f4 lbv[2][2];
        if (kind == 1) {
            const float* lb = (const float*)(ws + WS_LB);
#pragma unroll
            for (int bj = 0; bj < 2; ++bj)
#pragma unroll
                for (int n = 0; n < 2; ++n) lbv[bj][n] = *(const f4*)(lb + col0 + bj * HALF + 4 * n);
        }
        if (kind == 5 && wc >= 2) return;
#pragma unroll
        for (int ai = 0; ai < 2; ++ai)
#pragma unroll
            for (int m = 0; m < 4; ++m) {
                unsigned short* rowp = base + (size_t)(row0 + ai * HALF + m * 16) * ldc + col0;
#pragma unroll
                for (int bj = 0; bj < 2; ++bj) {
                    if (kind == 5 && bj == 1) continue;
                    f4 v0 = acc[ai][bj][m][0], v1 = acc[ai][bj][m][1];
                    u4 w;
                    if (kind == 1) {
                        typedef _Float16 h2 __attribute__((ext_vector_type(2)));
                        float r[8];
#pragma unroll
                        for (int e = 0; e < 4; ++e) { const float l0 = lbv[bj][0][e], l1 = lbv[bj][1][e];
                            r[e] = __log2f(l0 + (1.0f - l0) * sigm(v0[e])); r[4 + e] = __log2f(l1 + (1.0f - l1) * sigm(v1[e])); }
                        h2 a = {(_Float16)r[0], (_Float16)r[1]}, b = {(_Float16)r[2], (_Float16)r[3]}, c = {(_Float16)r[4], (_Float16)r[5]}, d = {(_Float16)r[6], (_Float16)r[7]};
                        w.x = __builtin_bit_cast(unsigned, a); w.y = __builtin_bit_cast(unsigned, b); w.z = __builtin_bit_cast(unsigned, c); w.w = __builtin_bit_cast(unsigned, d);
                    } else {
                        if (kind == 0) { v0 = map_silu(v0); v1 = map_silu(v1); }
                        else if (kind == 3) { v0 = v0 * QSCALE; v1 = v1 * QSCALE; }
                        else if (kind == 4 || kind == 5) { v0 = map_sigm(v0); v1 = map_sigm(v1); }
                        else if (kind == 6) { f4 o0, o1; unpack8(*(const u4*)(rowp + bj * HALF), o0, o1); v0 = map_silu(v0) * o0; v1 = map_silu(v1) * o1; }
                        w = pack8(v0, v1);
                    }
                    *(u4*)(rowp + bj * HALF) = w;
                }
            }
    }
};

struct EpiGateMul {
    static constexpr bool PERM = true, AFTER_DRAIN = false;
    const unsigned short* gate; unsigned short* out; int addprev;
    __device__ __forceinline__ void operator()(const f4 (&acc)[2][2][4][2], const Unit& u, int wr, int wc, int fr, int fq) const {
        const int row0 = u.pm * BM + wr * 64 + fr, col0 = u.pn * BM + wc * 32 + 8 * fq;
#pragma unroll
        for (int ai = 0; ai < 2; ++ai)
#pragma unroll
            for (int m = 0; m < 4; ++m) {
                const size_t off = (size_t)(row0 + ai * HALF + m * 16) * 1024 + col0;
#pragma unroll
                for (int bj = 0; bj < 2; ++bj) {
                    f4 g0, g1; unpack8(*(const u4*)(gate + off + bj * HALF), g0, g1);
                    f4 v0 = acc[ai][bj][m][0] * g0, v1 = acc[ai][bj][m][1] * g1;
                    if (addprev) { f4 p0, p1; unpack8(*(const u4*)(out + off + bj * HALF), p0, p1); v0 = v0 + p0; v1 = v1 + p1; }
                    *(u4*)(out + off + bj * HALF) = pack8(v0, v1);
                }
            }
    }
};

struct EpiRowScale {
    static constexpr bool PERM = true, AFTER_DRAIN = false;
    const float* ss; unsigned short* out; int ldc; float scale;
    __device__ __forceinline__ void operator()(const f4 (&acc)[2][2][4][2], const Unit& u, int wr, int wc, int fr, int fq) const {
        const int row0 = u.pm * BM + wr * 64 + fr, col0 = u.pn * BM + wc * 32 + 8 * fq;
#pragma unroll
        for (int ai = 0; ai < 2; ++ai)
#pragma unroll
            for (int m = 0; m < 4; ++m) {
                const int row = row0 + ai * HALF + m * 16;
                const float rs = __builtin_amdgcn_rsqf(ss[row] * (1.0f / 1024.0f) + EPS) * scale;
#pragma unroll
                for (int bj = 0; bj < 2; ++bj)
                    *(u4*)(out + (size_t)row * ldc + col0 + bj * HALF) = pack8(acc[ai][bj][m][0] * rs, acc[ai][bj][m][1] * rs);
            }
    }
};

struct EpiStore {
    static constexpr bool PERM = true, AFTER_DRAIN = false;
    unsigned short* out; int ldc;
    __device__ __forceinline__ void operator()(const f4 (&acc)[2][2][4][2], const Unit& u, int wr, int wc, int fr, int fq) const {
        const int row0 = u.pm * BM + wr * 64 + fr, col0 = u.pn * BM + wc * 32 + 8 * fq;
#pragma unroll
        for (int ai = 0; ai < 2; ++ai)
#pragma unroll
            for (int m = 0; m < 4; ++m)
#pragma unroll
                for (int bj = 0; bj < 2; ++bj)
                    *(u4*)(out + (size_t)(row0 + ai * HALF + m * 16) * ldc + col0 + bj * HALF) = pack8(acc[ai][bj][m][0], acc[ai][bj][m][1]);
    }
};

struct EpiSwiglu {
    static constexpr bool PERM = true, AFTER_DRAIN = false;
    const float* ss; unsigned short* out;
    __device__ __forceinline__ void operator()(const f4 (&acc)[2][2][4][2], const Unit& u, int wr, int wc, int fr, int fq) const {
        const int row0 = u.pm * BM + wr * 64 + fr, col0 = u.pn * HALF + wc * 32 + 8 * fq;
#pragma unroll
        for (int ai = 0; ai < 2; ++ai)
#pragma unroll
            for (int m = 0; m < 4; ++m) {
                const int row = row0 + ai * HALF + m * 16;
                const float rs = __builtin_amdgcn_rsqf(ss[row] * (1.0f / 1024.0f) + EPS);
                const f4 g0 = acc[ai][0][m][0] * rs, g1 = acc[ai][0][m][1] * rs, u0 = acc[ai][1][m][0] * rs, u1 = acc[ai][1][m][1] * rs;
                *(u4*)(out + (size_t)row * DFF + col0) = pack8(map_silu(g0) * u0, map_silu(g1) * u1);
            }
    }
};

struct EpiResid {
    static constexpr bool PERM = false, AFTER_DRAIN = false;
    const float* base; float* hout; const float* g; unsigned short* hg; float* ssq;
    __device__ __forceinline__ void operator()(const f4 (&acc)[2][2][4][2], const Unit& u, int wr, int wc, int fr, int fq) const {
        const int row0 = u.pm * BM + wr * 64 + fr, col0 = u.pn * BM + wc * 32 + 4 * fq;
        f4 gv[2][2];
#pragma unroll
        for (int bj = 0; bj < 2; ++bj)
#pragma unroll
            for (int n = 0; n < 2; ++n) gv[bj][n] = hg ? *(const f4*)(g + col0 + bj * HALF + n * 16) : (f4){0.f, 0.f, 0.f, 0.f};
#pragma unroll
        for (int ai = 0; ai < 2; ++ai)
#pragma unroll
            for (int m = 0; m < 4; ++m) {
                const int row = row0 + ai * HALF + m * 16;
                const size_t off = (size_t)row * 1024 + col0;
                float s = 0.f;
#pragma unroll
                for (int bj = 0; bj < 2; ++bj)
#pragma unroll
                    for (int n = 0; n < 2; ++n) {
                        const f4 h = *(const f4*)(base + off + bj * HALF + n * 16) + acc[ai][bj][m][n];
                        *(f4*)(hout + off + bj * HALF + n * 16) = h;
                        s += (h[0] * h[0] + h[1] * h[1]) + (h[2] * h[2] + h[3] * h[3]);
                        if (hg) { const f4 q = h * gv[bj][n]; v2u w; w.x = pk2(q[0], q[1]); w.y = pk2(q[2], q[3]); *(v2u*)(hg + off + bj * HALF + n * 16) = w; }
                    }
                s += __shfl_xor(s, 16); s += __shfl_xor(s, 32);
                if (fq == 0) unsafeAtomicAdd(ssq + row, s);
            }
    }
};
}

struct Frame {
    LAS unsigned char* lds;
    int tid, lane, wave, vcu, G;
    unsigned char* ws; unsigned char* dout;
};

__device__ __forceinline__ void transpose_item(const float* W, int ldw, int K, int c0, int ncols, bf16* WT, LAS float* scr, int kb, int nb, int lane) {
    const int k0 = 64 * kb, n0 = 32 * nb;
#pragma unroll 8
    for (int i = 0; i < 32; ++i) { const int kk = 2 * i + (lane >> 5); const int n = n0 + (lane & 31);
        scr[kk * 33 + (lane & 31)] = (n < ncols) ? W[(size_t)(k0 + kk) * ldw + c0 + n] : 0.f; }
    asm volatile("s_waitcnt lgkmcnt(0)" ::: "memory");
    const int c = lane & 7;
#pragma unroll
    for (int j = 0; j < 4; ++j) { const int n = (lane >> 3) + 8 * j; const LAS float* s = scr + (8 * c) * 33 + n;
        v4u o; o.x = pk2(s[0 * 33], s[1 * 33]); o.y = pk2(s[2 * 33], s[3 * 33]); o.z = pk2(s[4 * 33], s[5 * 33]); o.w = pk2(s[6 * 33], s[7 * 33]);
        if (n0 + n < ncols) *(GAS v4u*)(WT + (size_t)(n0 + n) * K + k0 + 8 * c) = o; }
    asm volatile("s_waitcnt lgkmcnt(0)" ::: "memory");
}
__device__ __forceinline__ void transpose_job(Frame& F, const float* W, int ldw, int K, int c0, int ncols, bf16* WT, int dst0, int mode, int& cursor) {
    LAS float* scr = (LAS float*)(F.lds + F.wave * 16384);
    const int nblk = (ncols + 31) / 32, nitems = (K / 64) * nblk;
    const int gw = F.vcu * NWAVES + F.wave, NGW = F.G * NWAVES;
    int first = (gw - cursor) % NGW; if (first < 0) first += NGW;
    for (int it = first; it < nitems; it += NGW) {
        const int kb = it / nblk, nb = it % nblk;
        const int n0 = 32 * nb;
        const int drow = (mode == 0) ? (dst0 + n0) : (256 * (n0 / 128) + dst0 + (n0 % 128));
        transpose_item(W, ldw, K, c0 + n0, ncols - n0, WT + (size_t)drow * K, scr, kb, 0, F.lane);
    }
    cursor = (cursor + nitems) % NGW;
}
__device__ __forceinline__ void rms_row_to_bf16(const float* xrow, const float* g, bf16* orow, int lane) {
    const GAS f32x4* xr = (const GAS f32x4*)xrow + lane;
    const GAS f32x4* gr = (const GAS f32x4*)g + lane;
    f32x4 v[4]; float s = 0.f;
#pragma unroll
    for (int j = 0; j < 4; ++j) { v[j] = xr[64 * j]; s += (v[j].x * v[j].x + v[j].y * v[j].y) + (v[j].z * v[j].z + v[j].w * v[j].w); }
    const float r = __builtin_amdgcn_rsqf(wave_sum(s) * (1.f / 1024.f) + EPS);
    GAS unsigned long long* o8 = (GAS unsigned long long*)orow + lane;
#pragma unroll
    for (int j = 0; j < 4; ++j) { const f32x4 gg = gr[64 * j];
        o8[64 * j] = (unsigned long long)pk2(v[j].x * r * gg.x, v[j].y * r * gg.y) | ((unsigned long long)pk2(v[j].z * r * gg.z, v[j].w * r * gg.w) << 32); }
}

__device__ __forceinline__ void hgrn_naive(Frame& F, const float* g_norm) {
    bf16* QA = (bf16*)(F.ws + WS_QA); const half_t* LOGF = (const half_t*)(F.ws + WS_LOGF); const bf16* IB = (const bf16*)(F.ws + WS_I);
    LAS float* red = (LAS float*)F.lds;
    LAS float* red2 = red + 512;
    const int v = F.tid & 127, kg = F.tid >> 7;
    for (int unit = F.vcu; unit < 64; unit += F.G) {
        const int b = unit >> 3, h = unit & 7;
        float S[32];
#pragma unroll
        for (int j = 0; j < 32; ++j) S[j] = 0.f;
        const float gn = g_norm[v];
        for (int t = 0; t < T; ++t) {
            const size_t rowo = (size_t)(b * T + t) * 1024 + h * 128;
            const float iv = bf2f(IB[rowo + v]);
            float part = 0.f;
#pragma unroll
            for (int j8 = 0; j8 < 4; ++j8) {
                const v4u qw = *(const v4u*)(QA + rowo + kg * 32 + j8 * 8);
                const v4u lw = *(const v4u*)(LOGF + rowo + kg * 32 + j8 * 8);
                const unsigned qq[4] = {qw.x, qw.y, qw.z, qw.w}, ll[4] = {lw.x, lw.y, lw.z, lw.w};
#pragma unroll
                for (int e = 0; e < 4; ++e) {
                    typedef _Float16 h2 __attribute__((ext_vector_type(2)));
                    const h2 lh = __builtin_bit_cast(h2, ll[e]);
                    const float f0 = __builtin_amdgcn_exp2f((float)lh[0]), f1 = __builtin_amdgcn_exp2f((float)lh[1]);
                    const int j = j8 * 8 + 2 * e;
                    S[j] = f0 * S[j] + (1.0f - f0) * iv; part += S[j] * bflo(qq[e]);
                    S[j + 1] = f1 * S[j + 1] + (1.0f - f1) * iv; part += S[j + 1] * bfhi(qq[e]);
                }
            }
            red[kg * 128 + v] = part;
            __syncthreads();
            float o = 0.f;
            if (F.tid < 128) { o = (red[v] + red[128 + v]) + (red[256 + v] + red[384 + v]); const float ss = wave_sum(o * o); if (F.lane == 0) red2[F.wave] = ss; }
            __syncthreads();
            if (F.tid < 128) { const float r = __builtin_amdgcn_rsqf((red2[0] + red2[1]) * (1.0f / 128.0f) + EPS); QA[rowo + v] = (bf16)f2bf(o * r * gn); }
        }
        __syncthreads();
    }
}

__device__ __forceinline__ void compress_naive(Frame& F, const float* pe_k, const float* w1k, const float* w2k, const float* pe_v, const float* w1v, const float* w2v) {
    const bf16* KV = (const bf16*)(F.ws + WS_KV);
    LAS float* xs = (LAS float*)F.lds;
    LAS float* red = xs + 2048;
    LAS float* hs = red + 512;
    const int tid = F.tid;
    for (int it = F.vcu; it < NB * 4 * 127 * 2; it += F.G) {
        const int which = it & 1; int r = it >> 1; const int n = r % 127; r /= 127; const int g = r & 3, b = r >> 2;
        const float* pe = which ? pe_v : pe_k; const float* w1 = which ? w1v : w1k; const float* w2 = which ? w2v : w2k;
        for (int i = tid; i < 2048; i += NTHREADS) { const int l = i >> 6, d = i & 63;
            xs[i] = bf2f(KV[(size_t)(b * T + 16 * n + l) * 1536 + which * 256 + g * 64 + d]) + pe[i]; }
        __syncthreads();
        { const int j = tid & 127, part = tid >> 7; float a = 0.f;
          for (int i = part * 512; i < part * 512 + 512; ++i) a += xs[i] * w1[(size_t)i * 128 + j];
          red[part * 128 + j] = a; }
        __syncthreads();
        if (tid < 128) hs[tid] = silu((red[tid] + red[128 + tid]) + (red[256 + tid] + red[384 + tid]));
        __syncthreads();
        if (tid < 64) { float o = 0.f; for (int j = 0; j < 128; ++j) o += hs[j] * w2[j * 64 + tid];
            bf16* dst = (bf16*)(F.ws + (which ? WS_VC : WS_KC)); dst[((size_t)(b * 4 + g) * 128 + n) * 64 + tid] = (bf16)f2bf(o); }
        __syncthreads();
    }
}

__device__ __forceinline__ float dot64_bf(const LAS float* qs, const bf16* kr) {
    float d = 0.f;
#pragma unroll
    for (int k8 = 0; k8 < 8; ++k8) { const v4u w = *(const v4u*)(kr + k8 * 8);
        d += qs[k8 * 8] * bflo(w.x) + qs[k8 * 8 + 1] * bfhi(w.x) + qs[k8 * 8 + 2] * bflo(w.y) + qs[k8 * 8 + 3] * bfhi(w.y)
           + qs[k8 * 8 + 4] * bflo(w.z) + qs[k8 * 8 + 5] * bfhi(w.z) + qs[k8 * 8 + 6] * bflo(w.w) + qs[k8 * 8 + 7] * bfhi(w.w); }
    return d;
}
__device__ __forceinline__ void nsa_naive(Frame& F) {
    bf16* QATT = (bf16*)(F.ws + WS_QATT); const bf16* KV = (const bf16*)(F.ws + WS_KV); const bf16* KC = (const bf16*)(F.ws + WS_KC); const bf16* VC = (const bf16*)(F.ws + WS_VC);
    const bf16* GATES = (const bf16*)(F.ws + WS_GATES);
    const int sub = F.tid >> 8, w = (F.tid >> 6) & 3, lane = F.lane;
    LAS float* base = (LAS float*)(F.lds + sub * 16384);
    LAS float* q_s = base;
    LAS float* p_s = base + 256;
    LAS float* pc_s = base + 256 + 2048;
    LAS float* imp_s = pc_s + 512;
    LAS int* sel_s = (LAS int*)(imp_s + 32);
    for (int it0 = F.vcu * 2; it0 < NB * T * 4; it0 += F.G * 2) {
        const int it = it0 + sub; const int g = it & 3, t = (it >> 2) & (T - 1), b = it >> 13;
        const int h = g * 4 + w;
        const float slope2 = __builtin_amdgcn_exp2f(-0.5f * (float)(h + 1)) * LOG2E;
        const size_t row = (size_t)(b * T + t);
        q_s[w * 64 + lane] = bf2f(QATT[row * 1024 + h * 64 + lane]);
        __syncthreads();
        float s0 = -INFINITY, s1 = -INFINITY;
        { const int n0 = lane, n1 = lane + 64; const bf16* kcb = KC + (size_t)(b * 4 + g) * 128 * 64;
          if (16 * n0 + 31 <= t) s0 = dot64_bf(q_s + w * 64, kcb + n0 * 64) - slope2 * ((float)t - (16.0f * n0 + 15.5f));
          if (n1 < 127 && 16 * n1 + 31 <= t) s1 = dot64_bf(q_s + w * 64, kcb + n1 * 64) - slope2 * ((float)t - (16.0f * n1 + 15.5f)); }
        float mm = wave_max(fmaxf(s0, s1));
        if (!(mm > -INFINITY)) mm = 0.f;
        float p0 = __builtin_amdgcn_exp2f(s0 - mm), p1 = __builtin_amdgcn_exp2f(s1 - mm);
        float dsum = wave_sum(p0 + p1);
        if (!(dsum > 0.f)) dsum = 1.f;
        p0 /= dsum; p1 /= dsum;
        pc_s[w * 128 + lane] = p0; pc_s[w * 128 + 64 + lane] = p1;
        __syncthreads();
        float o_cmp = 0.f;
        { const bf16* vcb = VC + (size_t)(b * 4 + g) * 128 * 64;
          for (int n = 0; n < 127; ++n) o_cmp += pc_s[w * 128 + n] * bf2f(vcb[n * 64 + lane]); }
        if ((F.tid & 255) < 32) { const int s = F.tid & 255; float im = 0.f;
            for (int n = 4 * s - 1; n <= 4 * s + 3; ++n) if (n >= 0 && n < 127) im += ((pc_s[n] + pc_s[128 + n]) + pc_s[256 + n]) + pc_s[384 + n];
            imp_s[s] = im; }
        __syncthreads();
        if ((F.tid & 255) == 0) { const int cur = t >> 6; unsigned used = 0u; int cnt = 0;
            for (int i = 0; i < 8; ++i) { float best = -INFINITY; int bi = -1;
                for (int s = 0; s < 32; ++s) { if ((used >> s) & 1u) continue; if (64 * s > t) continue;
                    const float sc = imp_s[s] + ((s == 0 || s == cur || s == cur - 1) ? 1.0e4f : 0.0f); if (sc > best) { best = sc; bi = s; } }
                if (bi >= 0) used |= 1u << bi;
                sel_s[i] = bi; } }
        __syncthreads();
        float o_slc = 0.f;
        { float mx = -INFINITY;
          for (int i = 0; i < 8; ++i) { const int sb = sel_s[i]; const int kp = 64 * sb + lane; float sc = -INFINITY;
              if (sb >= 0 && kp <= t) sc = dot64_bf(q_s + w * 64, KV + (size_t)(b * T + kp) * 1536 + 512 + g * 64) - slope2 * (float)(t - kp);
              p_s[w * 512 + i * 64 + lane] = sc; mx = fmaxf(mx, sc); }
          mx = wave_max(mx);
          float sum = 0.f;
          for (int i = 0; i < 8; ++i) { const float e = __builtin_amdgcn_exp2f(p_s[w * 512 + i * 64 + lane] - mx); p_s[w * 512 + i * 64 + lane] = e; sum += e; }
          sum = wave_sum(sum);
          __syncthreads();
          for (int i = 0; i < 8; ++i) { const int sb = sel_s[i]; if (sb < 0) continue;
              const bf16* vb = KV + (size_t)(b * T + 64 * sb) * 1536 + 768 + g * 64 + lane;
              for (int kk = 0; kk < 64; ++kk) o_slc += p_s[w * 512 + i * 64 + kk] * bf2f(vb[(size_t)kk * 1536]); }
          o_slc /= sum; }
        __syncthreads();
        float o_win = 0.f;
        { float mx = -INFINITY;
          for (int i = 0; i < 8; ++i) { const int kp = t - 511 + i * 64 + lane; float sc = -INFINITY;
              if (kp >= 0) sc = dot64_bf(q_s + w * 64, KV + (size_t)(b * T + kp) * 1536 + 1024 + g * 64) - slope2 * (float)(t - kp);
              p_s[w * 512 + i * 64 + lane] = sc; mx = fmaxf(mx, sc); }
          mx = wave_max(mx);
          float sum = 0.f;
          for (int i = 0; i < 8; ++i) { const float e = __builtin_amdgcn_exp2f(p_s[w * 512 + i * 64 + lane] - mx); p_s[w * 512 + i * 64 + lane] = e; sum += e; }
          sum = wave_sum(sum);
          __syncthreads();
          for (int i = 0; i < 512; ++i) { const int kp = t - 511 + i; if (kp >= 0) o_win += p_s[w * 512 + i] * bf2f(KV[(size_t)(b * T + kp) * 1536 + 1280 + g * 64 + lane]); }
          o_win /= sum; }
        const float g0 = bf2f(GATES[row * 64 + h * 3 + 0]), g1 = bf2f(GATES[row * 64 + h * 3 + 1]), g2 = bf2f(GATES[row * 64 + h * 3 + 2]);
        QATT[row * 1024 + h * 64 + lane] = (bf16)f2bf(g0 * o_cmp + g1 * o_slc + g2 * o_win);
        __syncthreads();
    }
}

__device__ __forceinline__ void xattn_naive(Frame& F) {
    const bf16* QX = (const bf16*)(F.ws + WS_QX); const bf16* KVM = (const bf16*)(F.ws + WS_KVM); bf16* OX = (bf16*)(F.ws + WS_OX);
    const int sub = F.tid >> 8, t8 = F.tid & 255, lane = F.lane, w = (F.tid >> 6) & 3;
    LAS float* base = (LAS float*)(F.lds + sub * 4096);
    LAS float* q_s = base; LAS float* p_s = base + 128; LAS float* red = base + 384;
    for (int it0 = F.vcu * 2; it0 < NB * T * 4; it0 += F.G * 2) {
        const int it = it0 + sub; const int h = it & 3, t = (it >> 2) & (T - 1), b = it >> 13;
        const size_t row = (size_t)(b * T + t);
        if (t8 < 128) q_s[t8] = bf2f(QX[row * 512 + h * 128 + t8]);
        __syncthreads();
        const bf16* kr = KVM + (size_t)(b * NMEM + t8) * 1024 + h * 128;
        const float s = dot64_bf(q_s, kr) + dot64_bf(q_s + 64, kr + 64);
        float mx = wave_max(s);
        if (lane == 0) red[w] = mx;
        __syncthreads();
        mx = fmaxf(fmaxf(red[0], red[1]), fmaxf(red[2], red[3]));
        __syncthreads();
        const float e = __builtin_amdgcn_exp2f(s - mx);
        p_s[t8] = e;
        float sum = wave_sum(e);
        if (lane == 0) red[w] = sum;
        __syncthreads();
        sum = (red[0] + red[1]) + (red[2] + red[3]);
        if (t8 < 128) { float acc = 0.f;
            for (int mmi = 0; mmi < 256; ++mmi) acc += p_s[mmi] * bf2f(KVM[(size_t)(b * NMEM + mmi) * 1024 + 512 + h * 128 + t8]);
            OX[row * 512 + h * 128 + t8] = (bf16)f2bf(acc / sum); }
        __syncthreads();
    }
}

namespace nsa {
constexpr int KS = 72, VS = 96;
constexpr int KT_BYTES = 64 * KS * 2, VT_BYTES = 64 * VS * 2;
constexpr int L_K = 0, L_V = 2 * KT_BYTES, L_IMP = L_V + 2 * VT_BYTES, L_SEL = L_IMP + 64 * 33 * 4, L_UNI = L_SEL + 256, L_END = L_UNI + 16;
constexpr float NEG = -1.0e30f;
typedef short v4i16_t __attribute__((ext_vector_type(4)));

__device__ __forceinline__ int crow(int r, int hi) { return (r & 3) + 8 * (r >> 2) + 4 * hi; }
__device__ __forceinline__ float xhalf_max(float m) { auto rr = __builtin_amdgcn_permlane32_swap(__float_as_uint(m), __float_as_uint(m), false, false); return fmaxf(__uint_as_float(rr[0]), __uint_as_float(rr[1])); }
__device__ __forceinline__ float xhalf_sum(float m) { auto rr = __builtin_amdgcn_permlane32_swap(__float_as_uint(m), __float_as_uint(m), false, false); return __uint_as_float(rr[0]) + __uint_as_float(rr[1]); }

struct TileRegs { v4u k, v; };
__device__ __forceinline__ TileRegs load_tile(const bf16* Kg, const bf16* Vg, int ld, int tid) {
    const int row = tid >> 3, ch = tid & 7; TileRegs r;
    r.k = *(const v4u*)(Kg + (size_t)row * ld + ch * 8); r.v = *(const v4u*)(Vg + (size_t)row * ld + ch * 8); return r;
}
__device__ __forceinline__ void store_tile(LAS unsigned char* lds, int buf, const TileRegs& r, int tid) {
    const int row = tid >> 3, ch = tid & 7;
    *(LAS v4u*)(lds + L_K + buf * KT_BYTES + (row * KS + ch * 8) * 2) = r.k;
    *(LAS v4u*)(lds + L_V + buf * VT_BYTES + (row * VS + ch * 8) * 2) = r.v;
}
__device__ __forceinline__ void qk_tile(f32x16& p0, f32x16& p1, const LAS unsigned char* Kt, const bf16x8 (&qf)[4], int r32, int hi, float i0, float i1) {
#pragma unroll
    for (int r = 0; r < 16; ++r) { p0[r] = i0; p1[r] = i1; }
#pragma unroll
    for (int ks = 0; ks < 4; ++ks) {
        const bf16x8 a0 = *(const LAS bf16x8*)(Kt + (r32 * KS + 16 * ks + 8 * hi) * 2);
        const bf16x8 a1 = *(const LAS bf16x8*)(Kt + ((32 + r32) * KS + 16 * ks + 8 * hi) * 2);
        p0 = __builtin_amdgcn_mfma_f32_32x32x16_bf16(a0, qf[ks], p0, 0, 0, 0);
        p1 = __builtin_amdgcn_mfma_f32_32x32x16_bf16(a1, qf[ks], p1, 0, 0, 0);
    }
}
__device__ __forceinline__ bf16x8 pack_p(const f32x16& p, int s) {
    v4u w; w.x = pk2(p[8 * s + 0], p[8 * s + 1]); w.y = pk2(p[8 * s + 2], p[8 * s + 3]); w.z = pk2(p[8 * s + 4], p[8 * s + 5]); w.w = pk2(p[8 * s + 6], p[8 * s + 7]);
    return __builtin_bit_cast(bf16x8, w);
}
__device__ __forceinline__ s16x4 tr_read(const LAS unsigned char* p) { return __builtin_bit_cast(s16x4, __builtin_amdgcn_ds_read_tr16_b64_v4i16((LAS v4i16_t*)p)); }
template <int NDB>
__device__ __forceinline__ void pv_tile(f32x16 (&o)[NDB], const LAS unsigned char* Vt, int vstride, const f32x16& p0, const f32x16& p1, int lane) {
    const int hi = lane >> 5, i16 = lane & 15, g1 = (lane >> 4) & 1;
    const LAS unsigned char* vb = Vt + ((4 * hi + (i16 >> 2)) * vstride + 16 * g1 + 4 * (i16 & 3)) * 2;
#pragma unroll
    for (int half = 0; half < 2; ++half)
#pragma unroll
        for (int s = 0; s < 2; ++s) {
            const bf16x8 pf = pack_p(half ? p1 : p0, s);
#pragma unroll
            for (int db = 0; db < NDB; ++db) {
                const LAS unsigned char* a = vb + ((32 * half + 16 * s) * vstride + 32 * db) * 2;
                const s16x4 lo = tr_read(a), hi4 = tr_read(a + 8 * vstride * 2);
                const bf16x8 vf = (bf16x8){lo[0], lo[1], lo[2], lo[3], hi4[0], hi4[1], hi4[2], hi4[3]};
                o[db] = __builtin_amdgcn_mfma_f32_32x32x16_bf16(vf, pf, o[db], 0, 0, 0);
            }
        }
}
__device__ __forceinline__ void softmax_step(f32x16& p0, f32x16& p1, float& m, float& l, f32x16 (&o)[2]) {
    float a = fmaxf(p0[0], p1[0]);
#pragma unroll
    for (int r = 1; r < 16; ++r) a = fmaxf(a, fmaxf(p0[r], p1[r]));
    a = xhalf_max(a);
    const float mn = fmaxf(m, a), alpha = __builtin_amdgcn_exp2f(m - mn);
    float s = 0.f;
#pragma unroll
    for (int r = 0; r < 16; ++r) { p0[r] = __builtin_amdgcn_exp2f(p0[r] - mn); p1[r] = __builtin_amdgcn_exp2f(p1[r] - mn); s += p0[r] + p1[r]; }
    s = xhalf_sum(s);
    l = l * alpha + s; m = mn;
#pragma unroll
    for (int r = 0; r < 16; ++r) { o[0][r] *= alpha; o[1][r] *= alpha; }
}

__device__ __forceinline__ void unit(Frame& F, int b, int g, int qb) {
    LAS unsigned char* lds = F.lds;
    const int tid = F.tid, lane = F.lane, w = F.wave, hg = w >> 1, qh = w & 1, r32 = lane & 31, hi = lane >> 5;
    const int h = g * 4 + hg, qq = qh * 32 + r32, t = 64 * qb + qq;
    const size_t row = (size_t)b * T + t;
    bf16* QATT = (bf16*)(F.ws + WS_QATT); const bf16* KV = (const bf16*)(F.ws + WS_KV);
    const float slope2 = __builtin_amdgcn_exp2f(-0.5f * (float)(h + 1)) * LOG2E;
    bf16x8 qf[4];
#pragma unroll
    for (int ks = 0; ks < 4; ++ks) qf[ks] = *(const bf16x8*)(QATT + row * 1024 + h * 64 + 16 * ks + 8 * hi);
    const float sl4h = slope2 * (float)(4 * hi);
    const bf16* GATES = (const bf16*)(F.ws + WS_GATES);
    const float g0 = bf2f(GATES[row * 64 + h * 3 + 0]), g1 = bf2f(GATES[row * 64 + h * 3 + 1]), g2 = bf2f(GATES[row * 64 + h * 3 + 2]);
    LAS float* impL = (LAS float*)(lds + L_IMP);
    for (int i = tid; i < 64 * 33; i += NTHREADS) impL[i] = 0.f;
    f32x16 y[2];
    {
        const int ntile = (qb >= 16) ? 2 : 1;
        const bf16* KC = (const bf16*)(F.ws + WS_KC) + (size_t)(b * 4 + g) * 128 * 64; const bf16* VC = (const bf16*)(F.ws + WS_VC) + (size_t)(b * 4 + g) * 128 * 64;
        for (int tau = 0; tau < ntile; ++tau) { const TileRegs tr = load_tile(KC + tau * 64 * 64, VC + tau * 64 * 64, 64, tid); store_tile(lds, tau, tr, tid); }
        __syncthreads();
        const float cj = slope2 * ((float)t - 15.5f);
        const float sl16 = 16.0f * slope2;
        float m = NEG, l = 0.f;
        for (int tau = 0; tau < ntile; ++tau) {
            f32x16 p0, p1; const float b0 = 16.0f * sl4h + (float)(1024 * tau) * slope2 - cj;
            qk_tile(p0, p1, lds + L_K + tau * KT_BYTES, qf, r32, hi, b0, b0 + 512.0f * slope2);
            float a = NEG;
#pragma unroll
            for (int r = 0; r < 16; ++r) { const int n0 = 64 * tau + crow(r, hi), n1 = n0 + 32;
                p0[r] = (16 * n0 + 31 <= t) ? fmaf(sl16, (float)crow(r, 0), p0[r]) : NEG;
                p1[r] = (16 * n1 + 31 <= t) ? fmaf(sl16, (float)crow(r, 0), p1[r]) : NEG;
                a = fmaxf(a, fmaxf(p0[r], p1[r])); }
            a = xhalf_max(a);
            const float mn = fmaxf(m, a); float sacc = 0.f;
#pragma unroll
            for (int r = 0; r < 16; ++r) { const int n0 = 64 * tau + crow(r, hi), n1 = n0 + 32;
                sacc += ((16 * n0 + 31 <= t) ? __builtin_amdgcn_exp2f(p0[r] - mn) : 0.f) + ((16 * n1 + 31 <= t) ? __builtin_amdgcn_exp2f(p1[r] - mn) : 0.f); }
            l = l * __builtin_amdgcn_exp2f(m - mn) + xhalf_sum(sacc); m = mn;
        }
        const float inv = (l > 0.f) ? 1.0f / l : 0.f;
        f32x16 o[2];
#pragma unroll
        for (int r = 0; r < 16; ++r) { o[0][r] = 0.f; o[1][r] = 0.f; }
        for (int tau = 0; tau < ntile; ++tau) {
            f32x16 p0, p1; const float b0 = 16.0f * sl4h + (float)(1024 * tau) * slope2 - cj;
            qk_tile(p0, p1, lds + L_K + tau * KT_BYTES, qf, r32, hi, b0, b0 + 512.0f * slope2);
#pragma unroll
            for (int r = 0; r < 16; ++r) { const int n0 = 64 * tau + crow(r, hi), n1 = n0 + 32;
                p0[r] = (16 * n0 + 31 <= t) ? __builtin_amdgcn_exp2f(fmaf(sl16, (float)crow(r, 0), p0[r]) - m) * inv : 0.f;
                p1[r] = (16 * n1 + 31 <= t) ? __builtin_amdgcn_exp2f(fmaf(sl16, (float)crow(r, 0), p1[r]) - m) * inv : 0.f; }
#pragma unroll
            for (int i = 0; i < 4; ++i) {
                const int s0 = 16 * tau + 2 * i + hi, s1 = s0 + 8;
                __hip_atomic_fetch_add(&impL[qq * 33 + s0], (p0[4 * i] + p0[4 * i + 1]) + (p0[4 * i + 2] + p0[4 * i + 3]), __ATOMIC_RELAXED, __HIP_MEMORY_SCOPE_WORKGROUP);
                __hip_atomic_fetch_add(&impL[qq * 33 + s0 + 1], p0[4 * i + 3], __ATOMIC_RELAXED, __HIP_MEMORY_SCOPE_WORKGROUP);
                __hip_atomic_fetch_add(&impL[qq * 33 + s1], (p1[4 * i] + p1[4 * i + 1]) + (p1[4 * i + 2] + p1[4 * i + 3]), __ATOMIC_RELAXED, __HIP_MEMORY_SCOPE_WORKGROUP);
                if (s1 + 1 < 32) __hip_atomic_fetch_add(&impL[qq * 33 + s1 + 1], p1[4 * i + 3], __ATOMIC_RELAXED, __HIP_MEMORY_SCOPE_WORKGROUP);
            }
            pv_tile<2>(o, lds + L_V + tau * VT_BYTES, VS, p0, p1, lane);
        }
#pragma unroll
        for (int r = 0; r < 16; ++r) { y[0][r] = o[0][r] * g0; y[1][r] = o[1][r] * g0; }
    }
    __syncthreads();
    if (w == 0) {
        unsigned mask;
        if (qb <= 7) mask = (2u << qb) - 1u;
        else {
            float iv[32];
#pragma unroll
            for (int s = 0; s < 32; ++s) iv[s] = impL[lane * 33 + s];
            mask = 1u | (1u << qb) | (1u << (qb - 1));
#pragma unroll 1
            for (int pick = 0; pick < 5; ++pick) { float best = -1.0f; int bi = 1;
#pragma unroll
                for (int s = 1; s < 31; ++s) { const bool ok = (s <= qb - 2) && !((mask >> s) & 1u) && (iv[s] > best); best = ok ? iv[s] : best; bi = ok ? s : bi; }
                mask |= 1u << bi; }
        }
        ((LAS unsigned*)(lds + L_SEL))[lane] = mask;
        unsigned un = mask;
#pragma unroll
        for (int o = 1; o < 64; o <<= 1) un |= (unsigned)__shfl_xor((int)un, o);
        if (lane == 0) *(LAS unsigned*)(lds + L_UNI) = un;
    }
    __syncthreads();
    const unsigned selm = ((const LAS unsigned*)(lds + L_SEL))[qq];
    const unsigned uni = *(const LAS unsigned*)(lds + L_UNI);
    {
        float m = NEG, l = 0.f; f32x16 o[2];
#pragma unroll
        for (int r = 0; r < 16; ++r) { o[0][r] = 0.f; o[1][r] = 0.f; }
        const bf16* Kb = KV + (size_t)b * T * 1536 + 512 + g * 64; const bf16* Vb = KV + (size_t)b * T * 1536 + 768 + g * 64;
        unsigned rem = uni; int j = __builtin_ctz(rem); rem &= rem - 1u; int buf = 0;
        { const TileRegs tr = load_tile(Kb + (size_t)(64 * j) * 1536, Vb + (size_t)(64 * j) * 1536, 1536, tid); store_tile(lds, 0, tr, tid); }
        __syncthreads();
        for (;;) {
            const bool has_next = rem != 0u; int jn = 0; TileRegs tr;
            if (has_next) { jn = __builtin_ctz(rem); rem &= rem - 1u; tr = load_tile(Kb + (size_t)(64 * jn) * 1536, Vb + (size_t)(64 * jn) * 1536, 1536, tid); }
            const float b0 = sl4h - slope2 * (float)(t - 64 * j);
            f32x16 p0, p1; qk_tile(p0, p1, lds + L_K + buf * KT_BYTES, qf, r32, hi, b0, b0 + 32.0f * slope2);
            const bool sel = (selm >> j) & 1u;
            if (j == qb) {
#pragma unroll
                for (int r = 0; r < 16; ++r) { const int kk = crow(r, hi);
                    p0[r] = (sel && kk <= qq) ? fmaf(slope2, (float)crow(r, 0), p0[r]) : NEG; p1[r] = (sel && kk + 32 <= qq) ? fmaf(slope2, (float)crow(r, 0), p1[r]) : NEG; }
            } else {
#pragma unroll
                for (int r = 0; r < 16; ++r) { p0[r] = sel ? fmaf(slope2, (float)crow(r, 0), p0[r]) : NEG; p1[r] = sel ? fmaf(slope2, (float)crow(r, 0), p1[r]) : NEG; }
            }
            softmax_step(p0, p1, m, l, o);
            pv_tile<2>(o, lds + L_V + buf * VT_BYTES, VS, p0, p1, lane);
            if (has_next) store_tile(lds, buf ^ 1, tr, tid);
            __syncthreads();
            if (!has_next) break;
            buf ^= 1; j = jn;
        }
        const float sc = g1 / l;
#pragma unroll
        for (int r = 0; r < 16; ++r) { y[0][r] += o[0][r] * sc; y[1][r] += o[1][r] * sc; }
    }
    {
        float m = NEG, l = 0.f; f32x16 o[2];
#pragma unroll
        for (int r = 0; r < 16; ++r) { o[0][r] = 0.f; o[1][r] = 0.f; }
        const bf16* Kb = KV + (size_t)b * T * 1536 + 1024 + g * 64; const bf16* Vb = KV + (size_t)b * T * 1536 + 1280 + g * 64;
        const int jlast = (qb >= 8) ? qb - 8 : 0;
        int j = qb, buf = 0;
        { const TileRegs tr = load_tile(Kb + (size_t)(64 * j) * 1536, Vb + (size_t)(64 * j) * 1536, 1536, tid); store_tile(lds, 0, tr, tid); }
        __syncthreads();
        for (;;) {
            const bool has_next = j > jlast; TileRegs tr;
            if (has_next) tr = load_tile(Kb + (size_t)(64 * (j - 1)) * 1536, Vb + (size_t)(64 * (j - 1)) * 1536, 1536, tid);
            const float b0 = sl4h - slope2 * (float)(t - 64 * j);
            f32x16 p0, p1; qk_tile(p0, p1, lds + L_K + buf * KT_BYTES, qf, r32, hi, b0, b0 + 32.0f * slope2);
            if (j == qb) {
#pragma unroll
                for (int r = 0; r < 16; ++r) { const int kk = crow(r, hi);
                    p0[r] = (kk <= qq) ? fmaf(slope2, (float)crow(r, 0), p0[r]) : NEG; p1[r] = (kk + 32 <= qq) ? fmaf(slope2, (float)crow(r, 0), p1[r]) : NEG; }
            } else if (j == qb - 8) {
#pragma unroll
                for (int r = 0; r < 16; ++r) { const int kk = crow(r, hi);
                    p0[r] = (kk > qq) ? fmaf(slope2, (float)crow(r, 0), p0[r]) : NEG; p1[r] = (kk + 32 > qq) ? fmaf(slope2, (float)crow(r, 0), p1[r]) : NEG; }
            } else {
#pragma unroll
                for (int r = 0; r < 16; ++r) { p0[r] = fmaf(slope2, (float)crow(r, 0), p0[r]); p1[r] = fmaf(slope2, (float)crow(r, 0), p1[r]); }
            }
            softmax_step(p0, p1, m, l, o);
            pv_tile<2>(o, lds + L_V + buf * VT_BYTES, VS, p0, p1, lane);
            if (has_next) store_tile(lds, buf ^ 1, tr, tid);
            __syncthreads();
            if (!has_next) break;
            buf ^= 1; --j;
        }
        const float sc = g2 / l;
#pragma unroll
        for (int r = 0; r < 16; ++r) { y[0][r] += o[0][r] * sc; y[1][r] += o[1][r] * sc; }
    }
#pragma unroll
    for (int db = 0; db < 2; ++db)
#pragma unroll
        for (int i = 0; i < 4; ++i) { v2u wv; wv.x = pk2(y[db][4 * i], y[db][4 * i + 1]); wv.y = pk2(y[db][4 * i + 2], y[db][4 * i + 3]);
            *(v2u*)(QATT + row * 1024 + h * 64 + 32 * db + 8 * i + 4 * hi) = wv; }
}

__device__ __forceinline__ void phase(Frame& F) {
    for (int u = F.vcu; u < 1024; u += F.G) {
        const int slot = u >> 8, c = u & 255, bg = c >> 3, j = c & 7;
        const int qb = (slot == 0) ? 31 - j : (slot == 1) ? 16 + j : (slot == 2) ? 15 - j : j;
        unit(F, bg >> 2, bg & 3, qb);
        __syncthreads();
    }
}
}

namespace xat {
constexpr int KS = 136, VS = 160;
constexpr int KT_BYTES = 64 * KS * 2, VT_BYTES = 64 * VS * 2;
constexpr int L_K = 0, L_V = 2 * KT_BYTES;
struct TileRegs { v4u k[2], v[2]; };
__device__ __forceinline__ TileRegs load_tile(const bf16* Kg, const bf16* Vg, int tid) {
    const int row = tid >> 3, ch = tid & 7; TileRegs r;
    r.k[0] = *(const v4u*)(Kg + (size_t)row * 1024 + ch * 8); r.k[1] = *(const v4u*)(Kg + (size_t)row * 1024 + 64 + ch * 8);
    r.v[0] = *(const v4u*)(Vg + (size_t)row * 1024 + ch * 8); r.v[1] = *(const v4u*)(Vg + (size_t)row * 1024 + 64 + ch * 8); return r;
}
__device__ __forceinline__ void store_tile(LAS unsigned char* lds, int buf, const TileRegs& r, int tid) {
    const int row = tid >> 3, ch = tid & 7;
    *(LAS v4u*)(lds + L_K + buf * KT_BYTES + (row * KS + ch * 8) * 2) = r.k[0]; *(LAS v4u*)(lds + L_K + buf * KT_BYTES + (row * KS + 64 + ch * 8) * 2) = r.k[1];
    *(LAS v4u*)(lds + L_V + buf * VT_BYTES + (row * VS + ch * 8) * 2) = r.v[0]; *(LAS v4u*)(lds + L_V + buf * VT_BYTES + (row * VS + 64 + ch * 8) * 2) = r.v[1];
}
__device__ __forceinline__ void unit(Frame& F, int b, int hx, int qblk) {
    LAS unsigned char* lds = F.lds;
    const int tid = F.tid, lane = F.lane, w = F.wave, r32 = lane & 31, hi = lane >> 5;
    const size_t row = (size_t)b * T + qblk * 256 + w * 32 + r32;
    const bf16* QX = (const bf16*)(F.ws + WS_QX); const bf16* KVM = (const bf16*)(F.ws + WS_KVM) + (size_t)b * NMEM * 1024 + hx * 128; bf16* OX = (bf16*)(F.ws + WS_OX);
    bf16x8 qf[8];
#pragma unroll
    for (int ks = 0; ks < 8; ++ks) qf[ks] = *(const bf16x8*)(QX + row * 512 + hx * 128 + 16 * ks + 8 * hi);
    float m = nsa::NEG, l = 0.f; f32x16 o[4];
#pragma unroll
    for (int db = 0; db < 4; ++db)
#pragma unroll
        for (int r = 0; r < 16; ++r) o[db][r] = 0.f;
    { const TileRegs tr = load_tile(KVM, KVM + 512, tid); store_tile(lds, 0, tr, tid); }
    __syncthreads();
    int buf = 0;
#pragma unroll 1
    for (int j = 0; j < 4; ++j) {
        const bool has_next = j < 3; TileRegs tr;
        if (has_next) tr = load_tile(KVM + (size_t)(64 * (j + 1)) * 1024, KVM + (size_t)(64 * (j + 1)) * 1024 + 512, tid);
        f32x16 p0, p1;
#pragma unroll
        for (int r = 0; r < 16; ++r) { p0[r] = 0.f; p1[r] = 0.f; }
        const LAS unsigned char* Kt = lds + L_K + buf * KT_BYTES;
#pragma unroll
        for (int ks = 0; ks < 8; ++ks) {
            const bf16x8 a0 = *(const LAS bf16x8*)(Kt + (r32 * KS + 16 * ks + 8 * hi) * 2);
            const bf16x8 a1 = *(const LAS bf16x8*)(Kt + ((32 + r32) * KS + 16 * ks + 8 * hi) * 2);
            p0 = __builtin_amdgcn_mfma_f32_32x32x16_bf16(a0, qf[ks], p0, 0, 0, 0);
            p1 = __builtin_amdgcn_mfma_f32_32x32x16_bf16(a1, qf[ks], p1, 0, 0, 0);
        }
        float a = fmaxf(p0[0], p1[0]);
#pragma unroll
        for (int r = 1; r < 16; ++r) a = fmaxf(a, fmaxf(p0[r], p1[r]));
        a = nsa::xhalf_max(a);
        const float mn = fmaxf(m, a), alpha = __builtin_amdgcn_exp2f(m - mn);
        float s = 0.f;
#pragma unroll
        for (int r = 0; r < 16; ++r) { p0[r] = __builtin_amdgcn_exp2f(p0[r] - mn); p1[r] = __builtin_amdgcn_exp2f(p1[r] - mn); s += p0[r] + p1[r]; }
        s = nsa::xhalf_sum(s);
        l = l * alpha + s; m = mn;
#pragma unroll
        for (int db = 0; db < 4; ++db)
#pragma unroll
            for (int r = 0; r < 16; ++r) o[db][r] *= alpha;
        nsa::pv_tile<4>(o, lds + L_V + buf * VT_BYTES, VS, p0, p1, lane);
        if (has_next) store_tile(lds, buf ^ 1, tr, tid);
        __syncthreads();
        buf ^= 1;
    }
    const float inv = 1.0f / l;
#pragma unroll
    for (int db = 0; db < 4; ++db)
#pragma unroll
        for (int i = 0; i < 4; ++i) { v2u wv; wv.x = pk2(o[db][4 * i] * inv, o[db][4 * i + 1] * inv); wv.y = pk2(o[db][4 * i + 2] * inv, o[db][4 * i + 3] * inv);
            *(v2u*)(OX + row * 512 + hx * 128 + 32 * db + 8 * i + 4 * hi) = wv; }
}
__device__ __forceinline__ void phase(Frame& F) {
    for (int u = F.vcu; u < NB * 4 * 8; u += F.G) { unit(F, u >> 5, (u >> 3) & 3, u & 7); __syncthreads(); }
}
}

namespace hg {
constexpr int QS = 136, TS = 160;
constexpr int L_QD = 0, L_KD = L_QD + 64 * QS * 2, L_KE = L_KD + 64 * QS * 2, L_V = L_KE + 64 * TS * 2, L_S = L_V + 64 * TS * 2, L_TOT = L_S + 128 * TS * 2,
              L_BLAST = L_TOT + 8 * 128 * 4, L_SSQ = L_BLAST + 128 * 4, L_GN = L_SSQ + 4 * 64 * 4, L_END = L_GN + 128 * 4;
static_assert(L_END <= RING_BYTES, "hgrn LDS");
struct Raw { unsigned q[8], f[8], v[8]; };
__device__ __forceinline__ Raw load_raw(const bf16* QA, const half_t* LOGF, const bf16* IB, size_t base, int n, int w, int lane) {
    Raw r;
#pragma unroll
    for (int i = 0; i < 8; ++i) { const size_t o = base + (size_t)(n * 64 + 8 * w + i) * 1024 + 2 * lane;
        r.q[i] = *(const unsigned*)(QA + o); r.f[i] = *(const unsigned*)(LOGF + o); r.v[i] = *(const unsigned*)(IB + o); }
    return r;
}
__device__ __forceinline__ bf16x8 tr_frag(const LAS unsigned char* tile, int stride, int R0, int C0, int rstep, int lane) {
    const int i16 = lane & 15, g1 = (lane >> 4) & 1;
    const LAS unsigned char* a = tile + ((R0 + (i16 >> 2)) * stride + C0 + 16 * g1 + 4 * (i16 & 3)) * 2;
    const s16x4 lo = nsa::tr_read(a), hi4 = nsa::tr_read(a + rstep * stride * 2);
    return (bf16x8){lo[0], lo[1], lo[2], lo[3], hi4[0], hi4[1], hi4[2], hi4[3]};
}
__device__ __forceinline__ void unit(Frame& F, int b, int h, const float* g_norm) {
    LAS unsigned char* lds = F.lds;
    const int tid = F.tid, lane = F.lane, w = F.wave, r32 = lane & 31, hi = lane >> 5, cb = w & 1, vb = w >> 1;
    bf16* QA = (bf16*)(F.ws + WS_QA); const half_t* LOGF = (const half_t*)(F.ws + WS_LOGF); const bf16* IB = (const bf16*)(F.ws + WS_I);
    LAS float* totL = (LAS float*)(lds + L_TOT); LAS float* blastL = (LAS float*)(lds + L_BLAST); LAS float* ssqL = (LAS float*)(lds + L_SSQ); LAS float* gnL = (LAS float*)(lds + L_GN);
    for (int i = tid; i < 128 * TS * 2 / 4; i += NTHREADS) ((LAS unsigned*)(lds + L_S))[i] = 0u;
    if (tid < 128) gnL[tid] = g_norm[tid];
    f32x16 S0, S1;
#pragma unroll
    for (int r = 0; r < 16; ++r) { S0[r] = 0.f; S1[r] = 0.f; }
    const size_t base = (size_t)b * T * 1024 + h * 128;
    Raw nxt = load_raw(QA, LOGF, IB, base, 0, w, lane);
#pragma unroll 1
    for (int n = 0; n < 32; ++n) {
        const Raw cur = nxt;
        typedef _Float16 h2 __attribute__((ext_vector_type(2)));
        typedef float f2 __attribute__((ext_vector_type(2)));
        float bl0[8], bl1[8]; float s0 = 0.f, s1 = 0.f;
#pragma unroll
        for (int i = 0; i < 8; ++i) { const h2 lh = __builtin_bit_cast(h2, cur.f[i]); s0 += (float)lh[0]; s1 += (float)lh[1]; bl0[i] = s0; bl1[i] = s1; }
        *(LAS f2*)(totL + w * 128 + 2 * lane) = (f2){s0, s1};
        __syncthreads();
        if (n + 1 < 32) nxt = load_raw(QA, LOGF, IB, base, n + 1, w, lane);
        float off0 = 0.f, off1 = 0.f, all0 = 0.f, all1 = 0.f;
#pragma unroll
        for (int ww = 0; ww < 8; ++ww) { const f2 tt = *(const LAS f2*)(totL + ww * 128 + 2 * lane); all0 += tt[0]; all1 += tt[1]; if (ww < w) { off0 += tt[0]; off1 += tt[1]; } }
        if (w == 0) *(LAS f2*)(blastL + 2 * lane) = (f2){all0, all1};
#pragma unroll
        for (int i = 0; i < 8; ++i) {
            const int rowl = 8 * w + i;
            const h2 lh = __builtin_bit_cast(h2, cur.f[i]);
            const float l0 = (float)lh[0], l1 = (float)lh[1];
            const float k0 = 1.0f - __builtin_amdgcn_exp2f(l0), k1 = 1.0f - __builtin_amdgcn_exp2f(l1);
            const float b0 = off0 + bl0[i], b1 = off1 + bl1[i];
            const float q0 = bflo(cur.q[i]), q1 = bfhi(cur.q[i]);
            *(LAS unsigned*)(lds + L_QD + (rowl * QS + 2 * lane) * 2) = pk2(q0 * __builtin_amdgcn_exp2f(b0), q1 * __builtin_amdgcn_exp2f(b1));
            *(LAS unsigned*)(lds + L_KD + (rowl * QS + 2 * lane) * 2) = pk2(k0 * __builtin_amdgcn_exp2f(-b0), k1 * __builtin_amdgcn_exp2f(-b1));
            *(LAS unsigned*)(lds + L_KE + (rowl * TS + 2 * lane) * 2) = pk2(k0 * __builtin_amdgcn_exp2f(all0 - b0), k1 * __builtin_amdgcn_exp2f(all1 - b1));
            *(LAS unsigned*)(lds + L_V + (rowl * TS + 2 * lane) * 2) = cur.v[i];
        }
        __syncthreads();
        bf16x8 bq[8];
#pragma unroll
        for (int ks = 0; ks < 8; ++ks) bq[ks] = *(const LAS bf16x8*)(lds + L_QD + ((32 * cb + r32) * QS + 16 * ks + 8 * hi) * 2);
        f32x16 O;
#pragma unroll
        for (int r = 0; r < 16; ++r) O[r] = 0.f;
#pragma unroll
        for (int sb = 0; sb < 2; ++sb) {
            if (sb <= cb) {
                f32x16 P;
#pragma unroll
                for (int r = 0; r < 16; ++r) P[r] = 0.f;
#pragma unroll
                for (int ks = 0; ks < 8; ++ks) { const bf16x8 a = *(const LAS bf16x8*)(lds + L_KD + ((32 * sb + r32) * QS + 16 * ks + 8 * hi) * 2);
                    P = __builtin_amdgcn_mfma_f32_32x32x16_bf16(a, bq[ks], P, 0, 0, 0); }
                if (sb == cb) {
#pragma unroll
                    for (int r = 0; r < 16; ++r) if (nsa::crow(r, hi) > r32) P[r] = 0.f;
                }
#pragma unroll
                for (int s = 0; s < 2; ++s) {
                    const bf16x8 pf = nsa::pack_p(P, s);
                    const bf16x8 vf = tr_frag(lds + L_V, TS, 32 * sb + 16 * s + 4 * hi, 32 * vb, 8, lane);
                    O = __builtin_amdgcn_mfma_f32_32x32x16_bf16(vf, pf, O, 0, 0, 0);
                }
            }
        }
#pragma unroll
        for (int ks = 0; ks < 8; ++ks) { const bf16x8 sf = tr_frag(lds + L_S, TS, 16 * ks + 8 * hi, 32 * vb, 4, lane);
            O = __builtin_amdgcn_mfma_f32_32x32x16_bf16(sf, bq[ks], O, 0, 0, 0); }
        { float q = 0.f;
#pragma unroll
          for (int r = 0; r < 16; ++r) q += O[r] * O[r];
          q = nsa::xhalf_sum(q);
          if (hi == 0) ssqL[vb * 64 + 32 * cb + r32] = q; }
        { const float d0 = __builtin_amdgcn_exp2f(blastL[64 * cb + r32]), d1 = __builtin_amdgcn_exp2f(blastL[64 * cb + 32 + r32]);
#pragma unroll
          for (int r = 0; r < 16; ++r) { S0[r] *= d0; S1[r] *= d1; }
#pragma unroll
          for (int ss = 0; ss < 4; ++ss) {
              const bf16x8 vf = tr_frag(lds + L_V, TS, 16 * ss + 8 * hi, 32 * vb, 4, lane);
              const bf16x8 k0f = tr_frag(lds + L_KE, TS, 16 * ss + 8 * hi, 64 * cb, 4, lane);
              const bf16x8 k1f = tr_frag(lds + L_KE, TS, 16 * ss + 8 * hi, 64 * cb + 32, 4, lane);
              S0 = __builtin_amdgcn_mfma_f32_32x32x16_bf16(vf, k0f, S0, 0, 0, 0);
              S1 = __builtin_amdgcn_mfma_f32_32x32x16_bf16(vf, k1f, S1, 0, 0, 0);
          } }
        __syncthreads();
#pragma unroll
        for (int i = 0; i < 4; ++i) {
            v2u a; a.x = pk2(S0[4 * i], S0[4 * i + 1]); a.y = pk2(S0[4 * i + 2], S0[4 * i + 3]);
            v2u c; c.x = pk2(S1[4 * i], S1[4 * i + 1]); c.y = pk2(S1[4 * i + 2], S1[4 * i + 3]);
            *(LAS v2u*)(lds + L_S + ((64 * cb + r32) * TS + 32 * vb + 8 * i + 4 * hi) * 2) = a;
            *(LAS v2u*)(lds + L_S + ((64 * cb + 32 + r32) * TS + 32 * vb + 8 * i + 4 * hi) * 2) = c;
        }
        { const int c = 32 * cb + r32;
          const float tot = (ssqL[c] + ssqL[64 + c]) + (ssqL[128 + c] + ssqL[192 + c]);
          const float rs = __builtin_amdgcn_rsqf(tot * (1.0f / 128.0f) + EPS);
          bf16* orow = QA + base + (size_t)(n * 64 + c) * 1024 + 32 * vb + 4 * hi;
#pragma unroll
          for (int i = 0; i < 4; ++i) { const f32x4 g4 = *(const LAS f32x4*)(gnL + 32 * vb + 8 * i + 4 * hi);
              v2u wv; wv.x = pk2(O[4 * i] * rs * g4[0], O[4 * i + 1] * rs * g4[1]); wv.y = pk2(O[4 * i + 2] * rs * g4[2], O[4 * i + 3] * rs * g4[3]);
              *(v2u*)(orow + 8 * i) = wv; } }
    }
    __syncthreads();
}
__device__ __forceinline__ void phase(Frame& F, const float* g_norm) {
    for (int u = F.vcu; u < 64; u += F.G) unit(F, u >> 3, u & 7, g_norm);
}
}

namespace cmpr {
constexpr int XS = 72;
constexpr int L_X = 0, L_PART = 16 * 34 * XS * 2, L_HID = L_PART + 2 * 128 * 32 * 4, L_END = L_HID + 32 * 129 * 4;
static_assert(L_END <= RING_BYTES, "compress LDS");
__device__ __forceinline__ void unit(Frame& F, int b, int g, int which, int nq, const float* w2, const float* c1) {
    LAS unsigned char* lds = F.lds;
    const int tid = F.tid, lane = F.lane, w = F.wave, r32 = lane & 31, hi = lane >> 5, jb = w & 3, kh = w >> 2;
    const bf16* KV = (const bf16*)(F.ws + WS_KV) + (size_t)b * T * 1536 + which * 256 + g * 64;
    const bf16* W1T = (const bf16*)(F.ws + (which ? WS_WC1V : WS_WC1K));
    for (int c = tid; c < 528 * 8; c += NTHREADS) {
        const int tl = c >> 3, ch = c & 7; int tg = 512 * nq + tl; tg = tg > T - 1 ? T - 1 : tg;
        const v4u v = *(const v4u*)(KV + (size_t)tg * 1536 + ch * 8);
        *(LAS v4u*)(lds + L_X + (((tl & 15) * 34 + (tl >> 4)) * XS + ch * 8) * 2) = v;
    }
    __syncthreads();
    f32x16 acc;
#pragma unroll
    for (int r = 0; r < 16; ++r) acc[r] = 0.f;
    const bf16* wrow = W1T + (size_t)(32 * jb + r32) * 2048 + 8 * hi;
#pragma unroll 2
    for (int li = 0; li < 16; ++li) {
        const int l = 16 * kh + li;
        const int slot = (l & 15) * 34 + r32 + (l >> 4);
#pragma unroll
        for (int ks = 0; ks < 4; ++ks) {
            const bf16x8 a = *(const bf16x8*)(wrow + 64 * l + 16 * ks);
            const bf16x8 x = *(const LAS bf16x8*)(lds + L_X + (slot * XS + 16 * ks + 8 * hi) * 2);
            acc = __builtin_amdgcn_mfma_f32_32x32x16_bf16(a, x, acc, 0, 0, 0);
        }
    }
    LAS float* part = (LAS float*)(lds + L_PART);
#pragma unroll
    for (int r = 0; r < 16; ++r) part[(kh * 128 + 32 * jb + nsa::crow(r, hi)) * 32 + r32] = acc[r];
    __syncthreads();
    LAS float* hid = (LAS float*)(lds + L_HID);
    { const int n = tid & 31, j0 = (tid >> 5) * 8;
#pragma unroll
      for (int e = 0; e < 8; ++e) { const int j = j0 + e; hid[n * 129 + j] = silu(part[j * 32 + n] + part[(128 + j) * 32 + n] + c1[j]); } }
    __syncthreads();
    { const int n = tid >> 4, d4 = (tid & 15) * 4; f32x4 o = (f32x4){0.f, 0.f, 0.f, 0.f};
      for (int j = 0; j < 128; ++j) { const float hv = hid[n * 129 + j]; const f32x4 wv = *(const f32x4*)(w2 + j * 64 + d4); o += hv * wv; }
      const int ng = 32 * nq + n;
      if (ng < 127) { bf16* dst = (bf16*)(F.ws + (which ? WS_VC : WS_KC)) + ((size_t)(b * 4 + g) * 128 + ng) * 64 + d4;
          v2u wv; wv.x = pk2(o[0], o[1]); wv.y = pk2(o[2], o[3]); *(v2u*)dst = wv; } }
    __syncthreads();
}
__device__ __forceinline__ void phase(Frame& F, const float* w2k, const float* w2v) {
    const float* c1 = (const float*)(F.ws + WS_LB + 4096);
    for (int u = F.vcu; u < 256; u += F.G) { const int nq = u & 3, which = (u >> 2) & 1, g = (u >> 3) & 3, b = u >> 5;
        unit(F, b, g, which, nq, which ? w2v : w2k, c1 + which * 128); }
}
__device__ __forceinline__ void c1_prologue(Frame& F, int which, const float* pe, const float* w1) {
    LAS float* red = (LAS float*)F.lds;
    const int j = F.tid & 127, part = F.tid >> 7; float a = 0.f;
    for (int i = part * 512; i < part * 512 + 512; ++i) a += pe[i] * w1[(size_t)i * 128 + j];
    red[part * 128 + j] = a;
    __syncthreads();
    if (F.tid < 128) ((float*)(F.ws + WS_LB + 4096))[which * 128 + F.tid] = (red[F.tid] + red[128 + F.tid]) + (red[256 + F.tid] + red[384 + F.tid]);
    __syncthreads();
}
}

#ifndef MK_PER_PHASE_LAUNCH
#define MK_PER_PHASE_LAUNCH 0
#endif
constexpr int N_PHASES = 13;
struct Args { const float* in[24]; float* out; unsigned char* ws; int ph_lo, ph_hi; };

__global__ void __launch_bounds__(NTHREADS, 2) mk_fwd(Args args) {
    extern __shared__ __attribute__((aligned(16))) unsigned char lds_raw[];
    Frame F;
    F.lds = (LAS unsigned char*)lds_raw;
    F.tid = threadIdx.x; F.lane = F.tid & 63; F.wave = __builtin_amdgcn_readfirstlane(F.tid >> 6);
    F.G = gridDim.x; { const int bx = blockIdx.x; F.vcu = (F.G % 8 == 0) ? (bx % 8) * (F.G / 8) + bx / 8 : bx; }
    F.ws = args.ws; F.dout = (unsigned char*)args.out;
    volatile LAS unsigned* MISC = (volatile LAS unsigned*)(F.lds + MISC_OFF);
    for (int u = F.tid; u < (LDS_BYTES - RING_BYTES) / 4; u += NTHREADS) ((LAS unsigned*)(F.lds + RING_BYTES))[u] = 0u;
    __syncthreads();
    unsigned* ctl = (unsigned*)(F.ws + WS_CTL);
    XcdBarrier bar; bar.bar = ctl + CW_BAR; bar.x = 0; bar.st = nullptr;
    if (!MK_PER_PHASE_LAUNCH) bar = xcd_barrier_post(ctl + CW_BAR, MISC + 8);
    const int lo = args.ph_lo, hi = args.ph_hi;
#define IN(k) (lo <= (k) && (k) < hi)
#define SEAM(k) do { if (IN(k) && IN((k) + 1)) xcd_barrier(bar); } while (0)
    unsigned char* ws = F.ws;
    const float* x = args.in[0];
    float* hbuf = args.out;
    float* ss1 = (float*)(ws + CTL_SS1); float* ss2 = (float*)(ws + CTL_SS2); float* ss3 = (float*)(ws + CTL_SS3);
    const int gw = F.vcu * NWAVES + F.wave, NGW = F.G * NWAVES;

    if (IN(0)) {
        int cur = 0;
        const float* w_in = args.in[3];
        bf16* WIN = (bf16*)(ws + WS_WIN);
        transpose_job(F, w_in, INW, 1024, 0, 3072, WIN, 0, 0, cur);
        transpose_job(F, w_in, INW, 1024, 3072, 1024, WIN, 7936, 0, cur);
        transpose_job(F, w_in, INW, 1024, 4096, 2560, WIN, 3072, 0, cur);
        transpose_job(F, w_in, INW, 1024, 6656, 48, WIN, 7680, 0, cur);
        transpose_job(F, w_in, INW, 1024, 6704, 2048, WIN, 5632, 0, cur);
        transpose_job(F, args.in[12], 1024, 1024, 0, 1024, (bf16*)(ws + WS_WPR), 0, 0, cur);
        transpose_job(F, args.in[13], 1024, 1024, 0, 1024, (bf16*)(ws + WS_WPA), 0, 0, cur);
        transpose_job(F, args.in[14], 1024, 1024, 0, 1024, (bf16*)(ws + WS_WOUT), 0, 0, cur);
        transpose_job(F, args.in[17], 512, 1024, 0, 512, (bf16*)(ws + WS_WXQ), 0, 0, cur);
        transpose_job(F, args.in[18], 1024, 1024, 0, 1024, (bf16*)(ws + WS_WXKV), 0, 0, cur);
        transpose_job(F, args.in[19], 1024, 512, 0, 1024, (bf16*)(ws + WS_WXO), 0, 0, cur);
        transpose_job(F, args.in[7], 128, 2048, 0, 128, (bf16*)(ws + WS_WC1K), 0, 0, cur);
        transpose_job(F, args.in[10], 128, 2048, 0, 128, (bf16*)(ws + WS_WC1V), 0, 0, cur);
        __syncthreads();
        for (int m = gw; m < M; m += NGW) rms_row_to_bf16(x + (size_t)m * 1024, args.in[2], (bf16*)(ws + WS_A) + (size_t)m * 1024, F.lane);
        for (int m = gw; m < NB * NMEM; m += NGW) rms_row_to_bf16(args.in[1] + (size_t)m * 1024, args.in[16], (bf16*)(ws + WS_MEMN) + (size_t)m * 1024, F.lane);
        if (blockIdx.x == 1) cmpr::c1_prologue(F, 0, args.in[6], args.in[7]);
        if (blockIdx.x == 2) cmpr::c1_prologue(F, 1, args.in[9], args.in[10]);
        if (blockIdx.x == 0) { const float* lbr = args.in[4]; float* lb = (float*)(ws + WS_LB);
            for (int c = F.tid; c < 1024; c += NTHREADS) lb[c] = 1.0f / (1.0f + __expf(lbr[1024 + c] - lbr[c])); }
    }
    SEAM(0);
    if (IN(1)) {
        { pg8::Gemm g{(const pg8::bf16_t*)(ws + WS_A), (const pg8::bf16_t*)(ws + WS_WIN), M, 31 * 256, 1024}; pg8::StaticOrder S; S.init(M, 31 * 256, F.G, (int)blockIdx.x);
          epi::EpiInProj E{ws, F.dout, 0};
          pg8::gemm_phase<epi::EpiInProj, pg8::StaticOrder, true, true>(F.lds, g, S, E); }
        { pg8::Gemm g{(const pg8::bf16_t*)(ws + WS_MEMN), (const pg8::bf16_t*)(ws + WS_WXKV), NB * NMEM, 1024, 1024}; pg8::StaticOrder S; S.init(NB * NMEM, 1024, F.G, (int)blockIdx.x);
          epi::EpiStore E{(unsigned short*)(ws + WS_KVM), 1024};
          pg8::gemm_phase<epi::EpiStore, pg8::StaticOrder, true, true>(F.lds, g, S, E); }
    }
    SEAM(1);
    if (IN(2)) {
        if (F.vcu < 64) hg::phase(F, args.in[5]);
        else { Frame F2 = F; F2.vcu = F.vcu - 64; F2.G = F.G - 64; cmpr::phase(F2, args.in[8], args.in[11]); }
    }
    SEAM(2);
    if (IN(3)) {
        nsa::phase(F);
        { pg8::Gemm g{(const pg8::bf16_t*)(ws + WS_A), (const pg8::bf16_t*)(ws + WS_WIN) + (size_t)31 * 256 * 1024, M, 1024, 1024}; pg8::StaticOrder S; S.init(M, 1024, F.G, (int)blockIdx.x);
          epi::EpiInProj E{ws, F.dout, 31};
          pg8::gemm_phase<epi::EpiInProj, pg8::StaticOrder, true, true>(F.lds, g, S, E); }
    }
    SEAM(3);
    if (IN(4)) {
        { pg8::Gemm g{(const pg8::bf16_t*)(ws + WS_QATT), (const pg8::bf16_t*)(ws + WS_WPA), M, 1024, 1024}; pg8::StaticOrder S; S.init(M, 1024, F.G, (int)blockIdx.x);
          epi::EpiGateMul E{(const unsigned short*)(F.dout + 32 * MiB), (unsigned short*)(ws + WS_MERGED), 0};
          pg8::gemm_phase<epi::EpiGateMul, pg8::StaticOrder, true, true>(F.lds, g, S, E); }
        { pg8::Gemm g{(const pg8::bf16_t*)(ws + WS_QA), (const pg8::bf16_t*)(ws + WS_WPR), M, 1024, 1024}; pg8::StaticOrder S; S.init(M, 1024, F.G, (int)blockIdx.x);
          epi::EpiGateMul E{(const unsigned short*)(F.dout), (unsigned short*)(ws + WS_MERGED), 1};
          pg8::gemm_phase<epi::EpiGateMul, pg8::StaticOrder, true, true>(F.lds, g, S, E); }
    }
    SEAM(4);
    if (IN(5)) {
        { pg8::Gemm g{(const pg8::bf16_t*)(ws + WS_MERGED), (const pg8::bf16_t*)(ws + WS_WOUT), M, 1024, 1024}; pg8::StaticOrder S; S.init(M, 1024, F.G, (int)blockIdx.x);
          epi::EpiResid E{x, hbuf, args.in[15], (unsigned short*)(ws + WS_A), ss1};
          pg8::gemm_phase<epi::EpiResid, pg8::StaticOrder, true, true>(F.lds, g, S, E); }
        int cur = 0;
        transpose_job(F, args.in[21], 2 * DFF, 1024, 0, DFF, (bf16*)(ws + WS_WGU), 0, 1, cur);
        transpose_job(F, args.in[21], 2 * DFF, 1024, DFF, DFF, (bf16*)(ws + WS_WGU), 128, 1, cur);
        transpose_job(F, args.in[22], 1024, DFF, 0, 1024, (bf16*)(ws + WS_WDN), 0, 0, cur);
    }
    SEAM(5);
    if (IN(6)) {
        pg8::Gemm g{(const pg8::bf16_t*)(ws + WS_A), (const pg8::bf16_t*)(ws + WS_WXQ), M, 512, 1024}; pg8::StaticOrder S; S.init(M, 512, F.G, (int)blockIdx.x);
        epi::EpiRowScale E{ss1, (unsigned short*)(ws + WS_QX), 512, XSCALE};
        pg8::gemm_phase<epi::EpiRowScale, pg8::StaticOrder, true, true>(F.lds, g, S, E);
    }
    SEAM(6);
    if (IN(7)) xat::phase(F);
    SEAM(7);
    if (IN(8)) {
        pg8::Gemm g{(const pg8::bf16_t*)(ws + WS_OX), (const pg8::bf16_t*)(ws + WS_WXO), M, 1024, 512}; pg8::StaticOrder S; S.init(M, 1024, F.G, (int)blockIdx.x);
        epi::EpiResid E{hbuf, hbuf, args.in[20], (unsigned short*)(ws + WS_QA), ss2};
        pg8::gemm_phase<epi::EpiResid, pg8::StaticOrder, true, true>(F.lds, g, S, E);
    }
    SEAM(8);
    if (IN(9)) {
        pg8::Gemm g{(const pg8::bf16_t*)(ws + WS_QA), (const pg8::bf16_t*)(ws + WS_WGU), M, 2 * DFF, 1024}; pg8::StaticOrder S; S.init(M, 2 * DFF, F.G, (int)blockIdx.x);
        epi::EpiSwiglu E{ss2, (unsigned short*)(ws + WS_ACT)};
        pg8::gemm_phase<epi::EpiSwiglu, pg8::StaticOrder, true, true>(F.lds, g, S, E);
    }
    SEAM(9);
    if (IN(10)) {
        pg8::Gemm g{(const pg8::bf16_t*)(ws + WS_ACT), (const pg8::bf16_t*)(ws + WS_WDN), M, 1024, DFF}; pg8::StaticOrder S; S.init(M, 1024, F.G, (int)blockIdx.x);
        epi::EpiResid E{hbuf, hbuf, nullptr, nullptr, ss3};
        pg8::gemm_phase<epi::EpiResid, pg8::StaticOrder, true, true>(F.lds, g, S, E);
    }
    SEAM(10);
    if (IN(11)) {
        const float* gf = args.in[23];
        for (int m = gw; m < M; m += NGW) {
            const float r = __builtin_amdgcn_rsqf(ss3[m] * (1.0f / 1024.0f) + EPS);
            GAS f32x4* hr = (GAS f32x4*)(hbuf + (size_t)m * 1024) + F.lane; const GAS f32x4* gr = (const GAS f32x4*)gf + F.lane;
#pragma unroll
            for (int j = 0; j < 4; ++j) { const f32x4 v = hr[64 * j], gg = gr[64 * j]; hr[64 * j] = v * r * gg; }
        }
    }
#undef IN
#undef SEAM
}

extern "C" void kernel_launch(void* const* d_in, const int* in_sizes, int n_in, void* d_out, int out_size, void* d_ws, size_t ws_size, hipStream_t stream) {
    static int grid = 0;
    if (grid == 0) {
        if (n_in != 24 || out_size != M * D || ws_size < WS_END) { fprintf(stderr, "kernel_launch: unexpected shapes (n_in %d out %d ws %zu)\n", n_in, out_size, ws_size); grid = -1; return; }
        int dev = 0, cus = 0, per_cu = 0;
        if (hipGetDevice(&dev) != hipSuccess || hipDeviceGetAttribute(&cus, hipDeviceAttributeMultiprocessorCount, dev) != hipSuccess) { grid = -1; return; }
        if (hipFuncSetAttribute((const void*)mk_fwd, hipFuncAttributeMaxDynamicSharedMemorySize, LDS_BYTES) != hipSuccess) { fprintf(stderr, "kernel_launch: hipFuncSetAttribute failed\n"); grid = -1; return; }
        if (hipOccupancyMaxActiveBlocksPerMultiprocessor(&per_cu, (const void*)mk_fwd, NTHREADS, LDS_BYTES) != hipSuccess || per_cu < 1) { fprintf(stderr, "kernel_launch: occupancy query says %d blocks per CU\n", per_cu); grid = -1; (void)hipGetLastError(); return; }
        (void)hipGetLastError();
        grid = cus;
    }
    if (grid < 0) return;
    if (hipMemsetAsync((char*)d_ws + WS_CTL, 0, CTL_ZERO_BYTES, stream) != hipSuccess) return;
    Args a{};
    for (int i = 0; i < 24; ++i) a.in[i] = (const float*)d_in[i];
    a.out = (float*)d_out; a.ws = (unsigned char*)d_ws;
#if MK_PER_PHASE_LAUNCH
    for (int p = 0; p < N_PHASES; ++p) { a.ph_lo = p; a.ph_hi = p + 1; hipLaunchKernelGGL(mk_fwd, dim3(grid), dim3(NTHREADS), LDS_BYTES, stream, a); }
#else
    a.ph_lo = 0; a.ph_hi = N_PHASES;
    hipLaunchKernelGGL(mk_fwd, dim3(grid), dim3(NTHREADS), LDS_BYTES, stream, a);
#endif
}
```

```cpp
#include <hip/hip_runtime.h>
#include <cstdio>
#include <cstdint>
namespace pg8 {
#define PG8_LAS __attribute__((address_space(3)))
typedef unsigned short bf16_t;
typedef short bf16x8 __attribute__((ext_vector_type(8)));
typedef float f32x4 __attribute__((ext_vector_type(4)));
typedef unsigned u32x4 __attribute__((ext_vector_type(4)));
constexpr int BM = 256, BK = 64, HALF = 128, HTB = HALF * BK * 2  , STAGE_BYTES = 8 * HTB, NXCD = 8, WGM = 8;

__host__ __device__ __forceinline__ int lds_byte(int r, int c) { const int st = (r >> 4) * 2 + (c >> 5), rr = r & 15, cc = c & 31, ob = rr * 64 + cc * 2; return st * 1024 + (ob ^ (((ob >> 9) & 1) << 5)); }
__host__ __device__ __forceinline__ void stage_rc(int b, int& R, int& C) { const int st = b / 1024, sb = b % 1024, swz = sb ^ (((sb >> 9) & 1) << 5); R = (st >> 1) * 16 + swz / 64; C = (st & 1) * 32 + (swz % 64) / 2; }
__host__ __device__ __forceinline__ int perm32(int rho) { const int n = rho >> 4, i = rho & 15; return 8 * (i >> 2) + 4 * n + (i & 3); }

struct Unit { int pm, pn; };
struct Gemm { const bf16_t* A; const bf16_t* Bt; int M, N, K; };

struct StaticOrder {
    int nM, nN, nwg, G, c;
    __host__ __device__ void init(int M, int N, int G_, int c_) { nM = M / BM; nN = N / BM; nwg = nM * nN; G = G_; c = c_; }
    __host__ __device__ bool next(int i, Unit& u) const {
        const long L = (long)i * G + c; if (L >= nwg) return false;
        int wgid = (int)L; { const int q = nwg / NXCD, r = nwg % NXCD, xcd = wgid % NXCD, off = wgid / NXCD; wgid = (xcd < r ? xcd * (q + 1) : r * (q + 1) + (xcd - r) * q) + off; }
        const int nig = WGM * nN, gid = wgid / nig, fm = gid * WGM, gsz = (nM - fm) < WGM ? (nM - fm) : WGM;
        u.pm = fm + ((wgid % nig) % gsz); u.pn = (wgid % nig) / gsz; return true;
    }
    __device__ __forceinline__ void a_ready(const Unit&) const {}
    __device__ __forceinline__ void done(const Unit&) const {}
};

__device__ __forceinline__ unsigned cvt_pk_bf16(float lo, float hi) { unsigned r; asm volatile("v_cvt_pk_bf16_f32 %0, %1, %2" : "=v"(r) : "v"(lo), "v"(hi)); return r; }
typedef float f32x2 __attribute__((ext_vector_type(2)));
__device__ __forceinline__ f32x2 gelu_pk(f32x2 v) {
    const f32x2 av = __builtin_elementwise_abs(v), d = av * 0.2316418882f + 1.0f;
    f32x2 t; t.x = __builtin_amdgcn_rcpf(d.x); t.y = __builtin_amdgcn_rcpf(d.y);
    f32x2 q = t * 0.5307027145f + (-0.7265760135f); q = q * t + 0.7107068705f; q = q * t + (-0.142248368f); q = q * t + 0.127414796f; q = q * t;
    const f32x2 s = (v * v) * (-0.72134752044f);
    f32x2 e; e.x = __builtin_amdgcn_exp2f(s.x); e.y = __builtin_amdgcn_exp2f(s.y);
    const f32x2 m = v * (q * e), r = v - m;
    f32x2 o; o.x = v.x < 0.f ? m.x : r.x; o.y = v.y < 0.f ? m.y : r.y; return o;
}

template <int ACT  > struct EpiBf16 {
    static constexpr bool PERM = true, AFTER_DRAIN = false; static_assert(ACT == 0 || ACT == 1, "EpiBf16: ACT is 0 (none) or 1 (gelu_pk)");
    bf16_t* O; int ldc; const float* bias; int split_cols; size_t split_stride; float scale0;
    __device__ __forceinline__ void operator()(const f32x4 (&acc)[2][2][4][2], const Unit& u, int wr, int wc, int fr, int fq) const {
        const int row0 = u.pm * BM + wr * 64 + fr; int colt = u.pn * BM; bf16_t* base = O;
        float sc = 1.f; if (split_cols) { const int t = colt / split_cols; base += (size_t)t * split_stride; colt -= t * split_cols; if (t == 0) sc = scale0; }
        const int col0 = colt + wc * 32 + 8 * fq, bcol0 = u.pn * BM + wc * 32 + 8 * fq;
        f32x4 bv[2][2];
#pragma unroll
        for (int bj = 0; bj < 2; ++bj)
#pragma unroll
            for (int n = 0; n < 2; ++n) bv[bj][n] = bias ? *(const f32x4*)(bias + bcol0 + bj * HALF + 4 * n) : (f32x4){0.f, 0.f, 0.f, 0.f};
#pragma unroll
        for (int ai = 0; ai < 2; ++ai)
#pragma unroll
            for (int m = 0; m < 4; ++m) { bf16_t* rowp = base + (size_t)(row0 + ai * HALF + m * 16) * ldc + col0;
#pragma unroll
                for (int bj = 0; bj < 2; ++bj) { f32x4 v0 = acc[ai][bj][m][0] + bv[bj][0], v1 = acc[ai][bj][m][1] + bv[bj][1];
                    if (ACT == 1) { f32x2 a = gelu_pk((f32x2){v0[0], v0[1]}), b = gelu_pk((f32x2){v0[2], v0[3]}), c = gelu_pk((f32x2){v1[0], v1[1]}), d = gelu_pk((f32x2){v1[2], v1[3]});
                        v0 = (f32x4){a.x, a.y, b.x, b.y}; v1 = (f32x4){c.x, c.y, d.x, d.y}; }
                    v0 = v0 * sc; v1 = v1 * sc; u32x4 w; w.x = cvt_pk_bf16(v0[0], v0[1]); w.y = cvt_pk_bf16(v0[2], v0[3]); w.z = cvt_pk_bf16(v1[0], v1[1]); w.w = cvt_pk_bf16(v1[2], v1[3]);
                    *(u32x4*)(rowp + bj * HALF) = w; } }
    }
};
template <class Epi, class Sched, bool ALIGN_EPI = false, bool SP2 = false>
__device__ __forceinline__ void gemm_phase(PG8_LAS unsigned char* lds, const Gemm g, const Sched& S, const Epi& E, const int wave_in) {
    int lane_; asm volatile("v_mbcnt_lo_u32_b32 %0, -1, 0\n\tv_mbcnt_hi_u32_b32 %0, -1, %0" : "=v"(lane_));
    const int wid = wave_in, lane = lane_, tid = wid * 64 + lane, wr = wid >> 2, wc = wid & 3, fr = lane & 15, fq = lane >> 4;
    const int K = g.K, nt = K / BK;
    unsigned voffA[2], voffB[2];
#pragma unroll
    for (int i = 0; i < 2; ++i) { int R, C; stage_rc(tid * 16 + i * 8192, R, C); const int Rb = Epi::PERM ? ((R & ~31) + perm32(R & 31)) : R;
        voffA[i] = (unsigned)(R * K + C) * 2u; voffB[i] = (unsigned)(Rb * K + C) * 2u; }
    const size_t kstep = (size_t)(BK * 2);
    const size_t hstep = (size_t)HALF * K * 2;
    const size_t tstep = 2 * hstep;
    const unsigned ldsw = (unsigned)wid * 1024u;
    const int aoff = lds_byte(wr * 64 + fr, fq * 8), boff = lds_byte(wc * 32 + fr, fq * 8);
#define PG8_SA(b, h) (((b) * 2 + (h)) * HTB)
#define PG8_SB(b, h) ((4 + (b) * 2 + (h)) * HTB)
#define PG8_STAGE(bufoff, gbase, voff) do { _Pragma("unroll") for (int _i = 0; _i < 2; ++_i) \
        __builtin_amdgcn_global_load_lds((const unsigned*)((const char*)(gbase) + (voff)[_i]), (PG8_LAS unsigned*)(lds + (bufoff) + ldsw + _i * 8192), 16, 0, 0); } while (0)
#define PG8_LDA(dst, b, h) do { _Pragma("unroll") for (int m = 0; m < 4; ++m) _Pragma("unroll") for (int k = 0; k < 2; ++k) dst[m][k] = *(const PG8_LAS bf16x8*)(lds + PG8_SA(b, h) + aoff + m * 2048 + k * 1024); } while (0)
#define PG8_LDB(dst, b, h) do { _Pragma("unroll") for (int n = 0; n < 2; ++n) _Pragma("unroll") for (int k = 0; k < 2; ++k) dst[n][k] = *(const PG8_LAS bf16x8*)(lds + PG8_SB(b, h) + boff + n * 2048 + k * 1024); } while (0)
#define PG8_MMA(ai, bj, At, Bt) do { __builtin_amdgcn_s_setprio(1); _Pragma("unroll") for (int m = 0; m < 4; ++m) _Pragma("unroll") for (int n = 0; n < 2; ++n) _Pragma("unroll") for (int k = 0; k < 2; ++k) \
        acc[ai][bj][m][n] = __builtin_amdgcn_mfma_f32_16x16x32_bf16(Bt[n][k], At[m][k], acc[ai][bj][m][n], 0, 0, 0); __builtin_amdgcn_s_setprio(0); } while (0)
#define PG8_WAIT_V(n) asm volatile("s_waitcnt vmcnt(" #n ")" ::: "memory")
#define PG8_WAIT_L(n) asm volatile("s_waitcnt lgkmcnt(" #n ")" ::: "memory")
#define PG8_BAR __builtin_amdgcn_s_barrier()
#define PG8_SCHED __builtin_amdgcn_sched_barrier(0)
    Unit cur, nxt; int ui = 0;
    if (!S.next(0, cur)) return;
    f32x4 acc[2][2][4][2];
#pragma unroll
    for (int a = 0; a < 2; ++a)
#pragma unroll
        for (int b = 0; b < 2; ++b)
#pragma unroll
            for (int m = 0; m < 4; ++m)
#pragma unroll
                for (int n = 0; n < 2; ++n) acc[a][b][m][n] = (f32x4){0.f, 0.f, 0.f, 0.f};
    bf16x8 At[4][2], B0[2][2], B1[2][2];
    const char* cA = (const char*)g.A + (size_t)cur.pm * tstep; const char* cB = (const char*)g.Bt + (size_t)cur.pn * tstep;
    S.a_ready(cur);
    if constexpr (SP2) {
        PG8_STAGE(PG8_SB(0, 0), cB, voffB); PG8_STAGE(PG8_SB(0, 1), cB + hstep, voffB); PG8_STAGE(PG8_SA(0, 0), cA, voffA); PG8_STAGE(PG8_SA(0, 1), cA + hstep, voffA);
        if (wr == 1) PG8_BAR;
        PG8_WAIT_V(2); PG8_BAR;
        PG8_STAGE(PG8_SB(1, 0), cB + kstep, voffB); PG8_STAGE(PG8_SA(1, 0), cA + kstep, voffA); PG8_STAGE(PG8_SB(1, 1), cB + hstep + kstep, voffB);
        PG8_WAIT_V(6); PG8_BAR;
    } else {
        PG8_STAGE(PG8_SB(0, 0), cB, voffB); PG8_STAGE(PG8_SA(0, 0), cA, voffA); PG8_STAGE(PG8_SB(0, 1), cB + hstep, voffB); PG8_STAGE(PG8_SA(0, 1), cA + hstep, voffA);
        if (wr == 1) PG8_BAR;
        PG8_WAIT_V(4); PG8_BAR;
        PG8_STAGE(PG8_SB(1, 0), cB + kstep, voffB); PG8_STAGE(PG8_SA(1, 0), cA + kstep, voffA); PG8_STAGE(PG8_SB(1, 1), cB + hstep + kstep, voffB);
        PG8_WAIT_V(6); PG8_BAR;
    }
    for (;;) {
        const bool has_next = S.next(ui + 1, nxt);
        const char* nA = has_next ? (const char*)g.A + (size_t)nxt.pm * tstep : cA; const char* nB = has_next ? (const char*)g.Bt + (size_t)nxt.pn * tstep : cB;
        for (int t = 0; t < nt; t += 2) {
            const bool last = (t == nt - 2);
            const char* a1 = cA + (size_t)(t + 1) * kstep;
            const char* a2 = last ? nA : cA + (size_t)(t + 2) * kstep; const char* b2 = last ? nB : cB + (size_t)(t + 2) * kstep;
            const char* a3 = a2 + kstep; const char* b3 = b2 + kstep;
            if (last && has_next) S.a_ready(nxt);
            if constexpr (SP2) {
            PG8_LDB(B0, 0, 0); PG8_LDB(B1, 0, 1); PG8_SCHED; PG8_LDA(At, 0, 0); PG8_STAGE(PG8_SA(1, 1), a1 + hstep, voffA);
            PG8_WAIT_V(8); PG8_WAIT_L(0); PG8_BAR; PG8_MMA(0, 0, At, B0); PG8_MMA(0, 1, At, B1); PG8_BAR; PG8_SCHED;
            PG8_LDA(At, 0, 1); PG8_STAGE(PG8_SB(0, 0), b2, voffB); PG8_STAGE(PG8_SB(0, 1), b2 + hstep, voffB); PG8_STAGE(PG8_SA(0, 0), a2, voffA);
            PG8_WAIT_V(8); PG8_WAIT_L(0); PG8_BAR; PG8_MMA(1, 0, At, B0); PG8_MMA(1, 1, At, B1); PG8_BAR; PG8_SCHED;
            PG8_LDB(B0, 1, 0); PG8_LDB(B1, 1, 1); PG8_SCHED; PG8_LDA(At, 1, 0); PG8_STAGE(PG8_SA(0, 1), a2 + hstep, voffA);
            PG8_WAIT_V(8); PG8_WAIT_L(0); PG8_BAR; PG8_MMA(0, 0, At, B0); PG8_MMA(0, 1, At, B1); PG8_BAR; PG8_SCHED;
            PG8_LDA(At, 1, 1); PG8_STAGE(PG8_SB(1, 0), b3, voffB); PG8_STAGE(PG8_SB(1, 1), b3 + hstep, voffB); PG8_STAGE(PG8_SA(1, 0), a3, voffA);
            PG8_WAIT_V(8); PG8_WAIT_L(0); PG8_BAR; PG8_MMA(1, 0, At, B0); PG8_MMA(1, 1, At, B1); PG8_BAR; PG8_SCHED;
            } else {
            PG8_LDB(B0, 0, 0); PG8_SCHED; PG8_LDA(At, 0, 0); PG8_STAGE(PG8_SA(1, 1), a1 + hstep, voffA);
            PG8_WAIT_L(8); PG8_BAR; PG8_WAIT_L(0); PG8_MMA(0, 0, At, B0); PG8_BAR; PG8_SCHED;
            PG8_LDB(B1, 0, 1); PG8_STAGE(PG8_SB(0, 0), b2, voffB);
            PG8_BAR; PG8_WAIT_L(0); PG8_MMA(0, 1, At, B1); PG8_BAR;
            PG8_LDA(At, 0, 1); PG8_STAGE(PG8_SA(0, 0), a2, voffA);
            PG8_BAR; PG8_WAIT_L(0); PG8_MMA(1, 0, At, B0); PG8_BAR; PG8_SCHED;
            PG8_STAGE(PG8_SB(0, 1), b2 + hstep, voffB);
            PG8_WAIT_V(6); PG8_BAR; PG8_MMA(1, 1, At, B1); PG8_BAR;
            PG8_LDB(B0, 1, 0); PG8_SCHED; PG8_LDA(At, 1, 0); PG8_STAGE(PG8_SA(0, 1), a2 + hstep, voffA);
            PG8_WAIT_L(8); PG8_BAR; PG8_WAIT_L(0); PG8_MMA(0, 0, At, B0); PG8_BAR; PG8_SCHED;
            PG8_LDB(B1, 1, 1); PG8_STAGE(PG8_SB(1, 0), b3, voffB);
            PG8_BAR; PG8_WAIT_L(0); PG8_MMA(0, 1, At, B1); PG8_BAR;
            PG8_LDA(At, 1, 1); PG8_STAGE(PG8_SA(1, 0), a3, voffA);
            PG8_BAR; PG8_WAIT_L(0); PG8_MMA(1, 0, At, B0); PG8_BAR; PG8_SCHED;
            PG8_STAGE(PG8_SB(1, 1), b3 + hstep, voffB);
            PG8_WAIT_V(6); PG8_BAR; PG8_MMA(1, 1, At, B1); PG8_BAR;
            }
        }
        if constexpr (ALIGN_EPI) { if (wr == 0) PG8_BAR; }
        if constexpr (!Epi::AFTER_DRAIN) { E(acc, cur, wr, wc, fr, fq); S.done(cur); }
        if (!has_next) break;
#pragma unroll
        for (int a = 0; a < 2; ++a)
#pragma unroll
            for (int b = 0; b < 2; ++b)
#pragma unroll
                for (int m = 0; m < 4; ++m)
#pragma unroll
                    for (int n = 0; n < 2; ++n) acc[a][b][m][n] = (f32x4){0.f, 0.f, 0.f, 0.f};
        cur = nxt; cA = nA; cB = nB; ++ui;
        if constexpr (ALIGN_EPI) { if (wr == 1) PG8_BAR; }
    }
    PG8_WAIT_V(0);
    if constexpr (!ALIGN_EPI) { if (wr == 0) PG8_BAR; }
    PG8_BAR;
    if constexpr (Epi::AFTER_DRAIN) { E.fused(acc, cur, wr, wc, fr, fq, lds, wid, lane); S.done(cur); }
#undef PG8_SA
#undef PG8_SB
#undef PG8_STAGE
#undef PG8_LDA
#undef PG8_LDB
#undef PG8_MMA
#undef PG8_WAIT_V
#undef PG8_WAIT_L
#undef PG8_BAR
#undef PG8_SCHED
}
}

#define GAS __attribute__((address_space(1)))
#define LAS __attribute__((address_space(3)))
typedef unsigned short bf16;
typedef unsigned v4u __attribute__((ext_vector_type(4)));
typedef unsigned v2u __attribute__((ext_vector_type(2)));
typedef float f32x4 __attribute__((ext_vector_type(4)));
typedef float f32x16 __attribute__((ext_vector_type(16)));
typedef short bf16x8 __attribute__((ext_vector_type(8)));
typedef short s16x4 __attribute__((ext_vector_type(4)));
typedef _Float16 half_t;

constexpr int NWAVES = 8, NTHREADS = 512;
constexpr int M = 16384, D = 1024, T = 2048, NB = 8, NMEM = 256, DFF = 2816, INW = 8752;
constexpr float EPS = 1e-6f;
constexpr float LOG2E = 1.4426950408889634f;
constexpr float QSCALE = 0.125f * LOG2E;
constexpr float XSCALE = 0.08838834764831845f * LOG2E;

constexpr size_t MiB = 1u << 20;
constexpr size_t WS_CTL = 0, CTL_ZERO_BYTES = 1 * MiB;
constexpr size_t CTL_SS1 = 256 * 1024, CTL_SS2 = 320 * 1024, CTL_SS3 = 384 * 1024;
constexpr int CW_BAR = 4096;
constexpr size_t WS_LB = 1 * MiB;
constexpr size_t WS_WIN = 2 * MiB;
constexpr size_t WS_WPR = 20 * MiB, WS_WPA = 22 * MiB, WS_WOUT = 24 * MiB, WS_WXQ = 26 * MiB, WS_WXKV = 27 * MiB, WS_WXO = 29 * MiB;
constexpr size_t WS_WC1K = 30 * MiB, WS_WC1V = 30 * MiB + 512 * 1024;
constexpr size_t WS_KC = 31 * MiB, WS_VC = 31 * MiB + 512 * 1024;
constexpr size_t WS_KVM = 32 * MiB;
constexpr size_t WS_GATES = 36 * MiB;
constexpr size_t WS_MEMN = 38 * MiB;
constexpr size_t WS_A = 42 * MiB;
constexpr size_t WS_QA = 74 * MiB;
constexpr size_t WS_LOGF = 106 * MiB;
constexpr size_t WS_WGU = 106 * MiB, WS_WDN = 117 * MiB;
constexpr size_t WS_YA = 106 * MiB;
constexpr size_t WS_I = 138 * MiB;
constexpr size_t WS_MERGED = 138 * MiB, WS_QX = 138 * MiB, WS_OX = 154 * MiB;
constexpr size_t WS_QATT = 170 * MiB;
constexpr size_t WS_KV = 202 * MiB;
constexpr size_t WS_ACT = 138 * MiB;
constexpr size_t WS_END = 250 * MiB;
static_assert(WS_ACT + (size_t)M * DFF * 2 <= WS_END && WS_WDN + (size_t)1024 * DFF * 2 <= WS_I, "ws map");

constexpr int RING_BYTES = 131072;
constexpr int MISC_OFF = RING_BYTES + 320;
constexpr int LDS_BYTES = 147456;

#define RLX_AGENT __ATOMIC_RELAXED, __HIP_MEMORY_SCOPE_AGENT
__device__ __forceinline__ unsigned f2bf(float f) { unsigned u = __builtin_bit_cast(unsigned, f); return (u + 0x7fffu + ((u >> 16) & 1u)) >> 16; }
typedef float f32x2_t __attribute__((ext_vector_type(2))); typedef __bf16 bf16x2_t __attribute__((ext_vector_type(2)));
__device__ __forceinline__ unsigned pk2(float lo, float hi) { f32x2_t v = {lo, hi}; bf16x2_t b = __builtin_convertvector(v, bf16x2_t); return __builtin_bit_cast(unsigned, b); }
__device__ __forceinline__ float bf2f(unsigned short b) { return __builtin_bit_cast(float, (unsigned)b << 16); }
__device__ __forceinline__ float bflo(unsigned w) { return __builtin_bit_cast(float, w << 16); }
__device__ __forceinline__ float bfhi(unsigned w) { return __builtin_bit_cast(float, w & 0xffff0000u); }
__device__ __forceinline__ float fast_exp(float x) { return __builtin_amdgcn_exp2f(x * LOG2E); }
__device__ __forceinline__ float fast_rcp(float x) { return __builtin_amdgcn_rcpf(x); }
__device__ __forceinline__ float sigm(float x) { return fast_rcp(1.0f + fast_exp(-x)); }
__device__ __forceinline__ float silu(float x) { return x * sigm(x); }
__device__ __forceinline__ float wave_sum(float v) {
#pragma unroll
    for (int o = 1; o < 64; o <<= 1) v += __shfl_xor(v, o);
    return v;
}
__device__ __forceinline__ float wave_max(float v) {
#pragma unroll
    for (int o = 1; o < 64; o <<= 1) v = fmaxf(v, __shfl_xor(v, o));
    return v;
}

__device__ __forceinline__ int lane_id_volatile() { int l; asm volatile("v_mbcnt_lo_u32_b32 %0, -1, 0\n\tv_mbcnt_hi_u32_b32 %0, -1, %0" : "=v"(l)); return l; }
#define XB_TMO      128
#define XB_XCNT(j)  (256  + 64 * (j))
#define XB_XSUB(j)  (1280 + 64 * (j))
#define XB_XGEN(j)  (2304 + 64 * (j))
#define XB_TOP      3328
#define XB_TOPGEN   3392
#define XCD_BAR_WORDS 3456
#define XB_SPIN_CAP (1u << 18)

__device__ __forceinline__ unsigned xb_ld(unsigned* p)              { return __hip_atomic_load(p, __ATOMIC_RELAXED, __HIP_MEMORY_SCOPE_AGENT); }
__device__ __forceinline__ unsigned xb_add(unsigned* p, unsigned v) { return __hip_atomic_fetch_add(p, v, __ATOMIC_RELAXED, __HIP_MEMORY_SCOPE_AGENT); }
__device__ __forceinline__ unsigned xb_xcc_id() { return (unsigned)__builtin_amdgcn_s_getreg((3 << 11) | 20) & 0xFu; }
#define XB_SPIN(cond, bar) do { unsigned _sp = 0; while (cond) { __builtin_amdgcn_s_sleep(1); \
    if ((++_sp & 255u) == 0u) { if (xb_ld(&(bar)[XB_TMO])) break; if (_sp > XB_SPIN_CAP) { atomicAdd(&(bar)[XB_TMO], 1u); break; } } } } while (0)

struct XcdBarrier {
    unsigned* bar; unsigned x;
    volatile LAS unsigned* st;
};

__device__ __forceinline__ XcdBarrier xcd_barrier_post(unsigned* bar, volatile LAS unsigned* st) {
    XcdBarrier b; b.bar = bar; b.x = xb_xcc_id(); b.st = st;
    if (threadIdx.x == 0) (void)xb_add(&bar[XB_XCNT(b.x)], 1u);
    return b;
}
__device__ __forceinline__ void xcd_barrier_complete(unsigned* bar, unsigned x, unsigned& nloc, unsigned& nx) {
    const unsigned G = gridDim.x * gridDim.y * gridDim.z;
    unsigned sum, cnt, mine, sp = 0u;
    for (;;) {
        sum = 0u; cnt = 0u; mine = 0u;
#pragma unroll
        for (unsigned j = 0; j < 16; ++j) { const unsigned c = xb_ld(&bar[XB_XCNT(j)]); sum += c; cnt += (c > 0u) ? 1u : 0u; mine = (j == x) ? c : mine; }
        if (sum == G) break;
        __builtin_amdgcn_s_sleep(1);
        if ((++sp & 255u) == 0u) { if (xb_ld(&bar[XB_TMO])) break; if (sp > XB_SPIN_CAP) { atomicAdd(&bar[XB_TMO], 1u); break; } }
    }
    nloc = mine > 0u ? mine : 1u; nx = cnt > 0u ? cnt : 1u;
}

__device__ __forceinline__ void xcd_barrier(const XcdBarrier& b) {
    asm volatile("s_waitcnt vmcnt(0)" ::: "memory");
    __syncthreads();
    if (threadIdx.x == 0) {
        unsigned* bar = b.bar;
        __builtin_amdgcn_s_waitcnt(0);
        unsigned nloc = b.st[0], nx = b.st[1];
        if (nloc == 0u) { xcd_barrier_complete(bar, b.x, nloc, nx); b.st[0] = nloc; b.st[1] = nx; }
        const unsigned old = xb_add(&bar[XB_XSUB(b.x)], 1u);
        const unsigned gen = old / nloc;
        if (old + 1u == (gen + 1u) * nloc) {
            __builtin_amdgcn_fence(__ATOMIC_RELEASE, "agent");
            asm volatile("s_waitcnt vmcnt(0)" ::: "memory");
            const unsigned og = xb_add(&bar[XB_TOP], 1u);
            const unsigned tg = og / nx;
            if (og + 1u == (tg + 1u) * nx) xb_add(&bar[XB_TOPGEN], 1u);
            else XB_SPIN(xb_ld(&bar[XB_TOPGEN]) == tg, bar);
            __builtin_amdgcn_fence(__ATOMIC_ACQUIRE, "agent");
            xb_add(&bar[XB_XGEN(b.x)], 1u);
            asm volatile("s_waitcnt vmcnt(0)" ::: "memory");
        } else {
            XB_SPIN(xb_ld(&bar[XB_XGEN(b.x)]) == gen, bar);
            __builtin_amdgcn_fence(__ATOMIC_ACQUIRE, "agent");
            asm volatile("s_waitcnt vmcnt(0)" ::: "memory");
        }
    }
    __syncthreads();
}

namespace epi {
using pg8::Unit; using pg8::HALF; using pg8::BM;
typedef pg8::f32x4 f4; typedef pg8::u32x4 u4;
__device__ __forceinline__ u4 pack8(f4 a, f4 b) { u4 w; w.x = pk2(a[0], a[1]); w.y = pk2(a[2], a[3]); w.z = pk2(b[0], b[1]); w.w = pk2(b[2], b[3]); return w; }
__device__ __forceinline__ void unpack8(u4 w, f4& a, f4& b) { a = (f4){bflo(w.x), bfhi(w.x), bflo(w.y), bfhi(w.y)}; b = (f4){bflo(w.z), bfhi(w.z), bflo(w.w), bfhi(w.w)}; }
__device__ __forceinline__ f4 map_sigm(f4 v) { return (f4){sigm(v[0]), sigm(v[1]), sigm(v[2]), sigm(v[3])}; }
__device__ __forceinline__ f4 map_silu(f4 v) { return (f4){silu(v[0]), silu(v[1]), silu(v[2]), silu(v[3])}; }

struct EpiInProj {
    static constexpr bool PERM = true, AFTER_DRAIN = false;
    unsigned char* ws; unsigned char* dout; int tile0;
    __device__ __forceinline__ void operator()(const f4 (&acc)[2][2][4][2], const Unit& u, int wr, int wc, int fr, int fq) const {
        const int ct = tile0 + u.pn;
        int kind, ldc, colt; unsigned short* base;
        if (ct < 4) { kind = 0; base = (unsigned short*)(ws + WS_QA); ldc = 1024; colt = ct * 256; }
        else if (ct < 8) { kind = 1; base = (unsigned short*)(ws + WS_LOGF); ldc = 1024; colt = (ct - 4) * 256; }
        else if (ct < 12) { kind = 2; base = (unsigned short*)(ws + WS_I); ldc = 1024; colt = (ct - 8) * 256; }
        else if (ct < 16) { kind = 3; base = (unsigned short*)(ws + WS_QATT); ldc = 1024; colt = (ct - 12) * 256; }
        else if (ct < 22) { kind = 2; base = (unsigned short*)(ws + WS_KV); ldc = 1536; colt = (ct - 16) * 256; }
        else if (ct < 26) { kind = 4; base = (unsigned short*)(dout); ldc = 1024; colt = (ct - 22) * 256; }
        else if (ct < 30) { kind = 4; base = (unsigned short*)(dout + 32 * MiB); ldc = 1024; colt = (ct - 26) * 256; }
        else if (ct == 30) { kind = 5; base = (unsigned short*)(ws + WS_GATES); ldc = 64; colt = 0; }
        else { kind = 6; base = (unsigned short*)(ws + WS_QA); ldc = 1024; colt = (ct - 31) * 256; }
        const int row0 = u.pm * BM + wr * 64 + fr;
        const int col0 = colt + wc * 32 + 8 * fq;
        f4 lbv[2][2];
        if (kind == 1) {
            const float* lb = (const float*)(ws + WS_LB);
#pragma unroll
            for (int bj = 0; bj < 2; ++bj)
#pragma unroll
                for (int n = 0; n < 2; ++n) lbv[bj][n] = *(const f4*)(lb + col0 + bj * HALF + 4 * n);
        }
        if (kind == 5 && wc >= 2) return;
#pragma unroll
        for (int ai = 0; ai < 2; ++ai)
#pragma unroll
            for (int m = 0; m < 4; ++m) {
                unsigned short* rowp = base + (size_t)(row0 + ai * HALF + m * 16) * ldc + col0;
#pragma unroll
                for (int bj = 0; bj < 2; ++bj) {
                    if (kind == 5 && bj == 1) continue;
                    f4 v0 = acc[ai][bj][m][0], v1 = acc[ai][bj][m][1];
                    u4 w;
                    if (kind == 1) {
                        typedef _Float16 h2 __attribute__((ext_vector_type(2)));
                        float r[8];
#pragma unroll
                        for (int e = 0; e < 4; ++e) { const float l0 = lbv[bj][0][e], l1 = lbv[bj][1][e];
                            r[e] = __log2f(l0 + (1.0f - l0) * sigm(v0[e])); r[4 + e] = __log2f(l1 + (1.0f - l1) * sigm(v1[e])); }
                        h2 a = {(_Float16)r[0], (_Float16)r[1]}, b = {(_Float16)r[2], (_Float16)r[3]}, c = {(_Float16)r[4], (_Float16)r[5]}, d = {(_Float16)r[6], (_Float16)r[7]};
                        w.x = __builtin_bit_cast(unsigned, a); w.y = __builtin_bit_cast(unsigned, b); w.z = __builtin_bit_cast(unsigned, c); w.w = __builtin_bit_cast(unsigned, d);
                    } else {
                        if (kind == 0) { v0 = map_silu(v0); v1 = map_silu(v1); }
                        else if (kind == 3) { v0 = v0 * QSCALE; v1 = v1 * QSCALE; }
                        else if (kind == 4 || kind == 5) { v0 = map_sigm(v0); v1 = map_sigm(v1); }
                        else if (kind == 6) { f4 o0, o1; unpack8(*(const u4*)(rowp + bj * HALF), o0, o1); v0 = map_silu(v0) * o0; v1 = map_silu(v1) * o1; }
                        w = pack8(v0, v1);
                    }
                    *(u4*)(rowp + bj * HALF) = w;
                }
            }
    }
};

struct EpiGateMul {
    static constexpr bool PERM = true, AFTER_DRAIN = false;
    const unsigned short* gate; unsigned short* out; int addprev;
    __device__ __forceinline__ void operator()(const f4 (&acc)[2][2][4][2], const Unit& u, int wr, int wc, int fr, int fq) const {
        const int row0 = u.pm * BM + wr * 64 + fr, col0 = u.pn * BM + wc * 32 + 8 * fq;
#pragma unroll
        for (int ai = 0; ai < 2; ++ai)
#pragma unroll
            for (int m = 0; m < 4; ++m) {
                const size_t off = (size_t)(row0 + ai * HALF + m * 16) * 1024 + col0;
#pragma unroll
                for (int bj = 0; bj < 2; ++bj) {
                    f4 g0, g1; unpack8(*(const u4*)(gate + off + bj * HALF), g0, g1);
                    f4 v0 = acc[ai][bj][m][0] * g0, v1 = acc[ai][bj][m][1] * g1;
                    if (addprev) { f4 p0, p1; unpack8(*(const u4*)(out + off + bj * HALF), p0, p1); v0 = v0 + p0; v1 = v1 + p1; }
                    *(u4*)(out + off + bj * HALF) = pack8(v0, v1);
                }
            }
    }
};

struct EpiRowScale {
    static constexpr bool PERM = true, AFTER_DRAIN = false;
    const float* ss; unsigned short* out; int ldc; float scale;
    __device__ __forceinline__ void operator()(const f4 (&acc)[2][2][4][2], const Unit& u, int wr, int wc, int fr, int fq) const {
        const int row0 = u.pm * BM + wr * 64 + fr, col0 = u.pn * BM + wc * 32 + 8 * fq;
#pragma unroll
        for (int ai = 0; ai < 2; ++ai)
#pragma unroll
            for (int m = 0; m < 4; ++m) {
                const int row = row0 + ai * HALF + m * 16;
                const float rs = __builtin_amdgcn_rsqf(ss[row] * (1.0f / 1024.0f) + EPS) * scale;
#pragma unroll
                for (int bj = 0; bj < 2; ++bj)
                    *(u4*)(out + (size_t)row * ldc + col0 + bj * HALF) = pack8(acc[ai][bj][m][0] * rs, acc[ai][bj][m][1] * rs);
            }
    }
};

struct EpiStore {
    static constexpr bool PERM = true, AFTER_DRAIN = false;
    unsigned short* out; int ldc;
    __device__ __forceinline__ void operator()(const f4 (&acc)[2][2][4][2], const Unit& u, int wr, int wc, int fr, int fq) const {
        const int row0 = u.pm * BM + wr * 64 + fr, col0 = u.pn * BM + wc * 32 + 8 * fq;
#pragma unroll
        for (int ai = 0; ai < 2; ++ai)
#pragma unroll
            for (int m = 0; m < 4; ++m)
#pragma unroll
                for (int bj = 0; bj < 2; ++bj)
                    *(u4*)(out + (size_t)(row0 + ai * HALF + m * 16) * ldc + col0 + bj * HALF) = pack8(acc[ai][bj][m][0], acc[ai][bj][m][1]);
    }
};

struct EpiSwiglu {
    static constexpr bool PERM = true, AFTER_DRAIN = false;
    const float* ss; unsigned short* out;
    __device__ __forceinline__ void operator()(const f4 (&acc)[2][2][4][2], const Unit& u, int wr, int wc, int fr, int fq) const {
        const int row0 = u.pm * BM + wr * 64 + fr, col0 = u.pn * HALF + wc * 32 + 8 * fq;
#pragma unroll
        for (int ai = 0; ai < 2; ++ai)
#pragma unroll
            for (int m = 0; m < 4; ++m) {
                const int row = row0 + ai * HALF + m * 16;
                const float rs = __builtin_amdgcn_rsqf(ss[row] * (1.0f / 1024.0f) + EPS);
                const f4 g0 = acc[ai][0][m][0] * rs, g1 = acc[ai][0][m][1] * rs, u0 = acc[ai][1][m][0] * rs, u1 = acc[ai][1][m][1] * rs;
                *(u4*)(out + (size_t)row * DFF + col0) = pack8(map_silu(g0) * u0, map_silu(g1) * u1);
            }
    }
};

struct EpiResid {
    static constexpr bool PERM = false, AFTER_DRAIN = false;
    const float* base; float* hout; const float* g; unsigned short* hg; float* ssq;
    __device__ __forceinline__ void operator()(const f4 (&acc)[2][2][4][2], const Unit& u, int wr, int wc, int fr, int fq) const {
        const int row0 = u.pm * BM + wr * 64 + fr, col0 = u.pn * BM + wc * 32 + 4 * fq;
        f4 gv[2][2];
#pragma unroll
        for (int bj = 0; bj < 2; ++bj)
#pragma unroll
            for (int n = 0; n < 2; ++n) gv[bj][n] = hg ? *(const f4*)(g + col0 + bj * HALF + n * 16) : (f4){0.f, 0.f, 0.f, 0.f};
#pragma unroll
        for (int ai = 0; ai < 2; ++ai)
#pragma unroll
            for (int m = 0; m < 4; ++m) {
                const int row = row0 + ai * HALF + m * 16;
                const size_t off = (size_t)row * 1024 + col0;
                float s = 0.f;
#pragma unroll
                for (int bj = 0; bj < 2; ++bj)
#pragma unroll
                    for (int n = 0; n < 2; ++n) {
                        const f4 h = *(const f4*)(base + off + bj * HALF + n * 16) + acc[ai][bj][m][n];
                        *(f4*)(hout + off + bj * HALF + n * 16) = h;
                        s += (h[0] * h[0] + h[1] * h[1]) + (h[2] * h[2] + h[3] * h[3]);
                        if (hg) { const f4 q = h * gv[bj][n]; v2u w; w.x = pk2(q[0], q[1]); w.y = pk2(q[2], q[3]); *(v2u*)(hg + off + bj * HALF + n * 16) = w; }
                    }
                s += __shfl_xor(s, 16); s += __shfl_xor(s, 32);
                if (fq == 0) unsafeAtomicAdd(ssq + row, s);
            }
    }
};
}

struct Frame {
    LAS unsigned char* lds;
    int tid, lane, wave, vcu, G;
    unsigned char* ws; unsigned char* dout;
};

__device__ __forceinline__ void transpose_item(const float* W, int ldw, int K, int c0, int ncols, bf16* WT, LAS float* scr, int kb, int nb, int lane) {
    const int k0 = 64 * kb, n0 = 32 * nb;
#pragma unroll 8
    for (int i = 0; i < 32; ++i) { const int kk = 2 * i + (lane >> 5); const int n = n0 + (lane & 31);
        scr[kk * 33 + (lane & 31)] = (n < ncols) ? W[(size_t)(k0 + kk) * ldw + c0 + n] : 0.f; }
    asm volatile("s_waitcnt lgkmcnt(0)" ::: "memory");
    const int c = lane & 7;
#pragma unroll
    for (int j = 0; j < 4; ++j) { const int n = (lane >> 3) + 8 * j; const LAS float* s = scr + (8 * c) * 33 + n;
        v4u o; o.x = pk2(s[0 * 33], s[1 * 33]); o.y = pk2(s[2 * 33], s[3 * 33]); o.z = pk2(s[4 * 33], s[5 * 33]); o.w = pk2(s[6 * 33], s[7 * 33]);
        if (n0 + n < ncols) *(GAS v4u*)(WT + (size_t)(n0 + n) * K + k0 + 8 * c) = o; }
    asm volatile("s_waitcnt lgkmcnt(0)" ::: "memory");
}
__device__ __forceinline__ void transpose_job(Frame& F, const float* W, int ldw, int K, int c0, int ncols, bf16* WT, int dst0, int mode, int& cursor) {
    LAS float* scr = (LAS float*)(F.lds + F.wave * 16384);
    const int nblk = (ncols + 31) / 32, nitems = (K / 64) * nblk;
    const int gw = F.vcu * NWAVES + F.wave, NGW = F.G * NWAVES;
    int first = (gw - cursor) % NGW; if (first < 0) first += NGW;
    for (int it = first; it < nitems; it += NGW) {
        const int kb = it / nblk, nb = it % nblk;
        const int n0 = 32 * nb;
        const int drow = (mode == 0) ? (dst0 + n0) : (256 * (n0 / 128) + dst0 + (n0 % 128));
        transpose_item(W, ldw, K, c0 + n0, ncols - n0, WT + (size_t)drow * K, scr, kb, 0, F.lane);
    }
    cursor = (cursor + nitems) % NGW;
}
__device__ __forceinline__ void rms_row_to_bf16(const float* xrow, const float* g, bf16* orow, int lane) {
    const GAS f32x4* xr = (const GAS f32x4*)xrow + lane;
    const GAS f32x4* gr = (const GAS f32x4*)g + lane;
    f32x4 v[4]; float s = 0.f;
#pragma unroll
    for (int j = 0; j < 4; ++j) { v[j] = xr[64 * j]; s += (v[j].x * v[j].x + v[j].y * v[j].y) + (v[j].z * v[j].z + v[j].w * v[j].w); }
    const float r = __builtin_amdgcn_rsqf(wave_sum(s) * (1.f / 1024.f) + EPS);
    GAS unsigned long long* o8 = (GAS unsigned long long*)orow + lane;
#pragma unroll
    for (int j = 0; j < 4; ++j) { const f32x4 gg = gr[64 * j];
        o8[64 * j] = (unsigned long long)pk2(v[j].x * r * gg.x, v[j].y * r * gg.y) | ((unsigned long long)pk2(v[j].z * r * gg.z, v[j].w * r * gg.w) << 32); }
}

__device__ __forceinline__ void hgrn_naive(Frame& F, const float* g_norm) {
    bf16* QA = (bf16*)(F.ws + WS_QA); const half_t* LOGF = (const half_t*)(F.ws + WS_LOGF); const bf16* IB = (const bf16*)(F.ws + WS_I);
    LAS float* red = (LAS float*)F.lds;
    LAS float* red2 = red + 512;
    const int v = F.tid & 127, kg = F.tid >> 7;
    for (int unit = F.vcu; unit < 64; unit += F.G) {
        const int b = unit >> 3, h = unit & 7;
        float S[32];
#pragma unroll
        for (int j = 0; j < 32; ++j) S[j] = 0.f;
        const float gn = g_norm[v];
        for (int t = 0; t < T; ++t) {
            const size_t rowo = (size_t)(b * T + t) * 1024 + h * 128;
            const float iv = bf2f(IB[rowo + v]);
            float part = 0.f;
#pragma unroll
            for (int j8 = 0; j8 < 4; ++j8) {
                const v4u qw = *(const v4u*)(QA + rowo + kg * 32 + j8 * 8);
                const v4u lw = *(const v4u*)(LOGF + rowo + kg * 32 + j8 * 8);
                const unsigned qq[4] = {qw.x, qw.y, qw.z, qw.w}, ll[4] = {lw.x, lw.y, lw.z, lw.w};
#pragma unroll
                for (int e = 0; e < 4; ++e) {
                    typedef _Float16 h2 __attribute__((ext_vector_type(2)));
                    const h2 lh = __builtin_bit_cast(h2, ll[e]);
                    const float f0 = __builtin_amdgcn_exp2f((float)lh[0]), f1 = __builtin_amdgcn_exp2f((float)lh[1]);
                    const int j = j8 * 8 + 2 * e;
                    S[j] = f0 * S[j] + (1.0f - f0) * iv; part += S[j] * bflo(qq[e]);
                    S[j + 1] = f1 * S[j + 1] + (1.0f - f1) * iv; part += S[j + 1] * bfhi(qq[e]);
                }
            }
            red[kg * 128 + v] = part;
            __syncthreads();
            float o = 0.f;
            if (F.tid < 128) { o = (red[v] + red[128 + v]) + (red[256 + v] + red[384 + v]); const float ss = wave_sum(o * o); if (F.lane == 0) red2[F.wave] = ss; }
            __syncthreads();
            if (F.tid < 128) { const float r = __builtin_amdgcn_rsqf((red2[0] + red2[1]) * (1.0f / 128.0f) + EPS); QA[rowo + v] = (bf16)f2bf(o * r * gn); }
        }
        __syncthreads();
    }
}

__device__ __forceinline__ void compress_naive(Frame& F, const float* pe_k, const float* w1k, const float* w2k, const float* pe_v, const float* w1v, const float* w2v) {
    const bf16* KV = (const bf16*)(F.ws + WS_KV);
    LAS float* xs = (LAS float*)F.lds;
    LAS float* red = xs + 2048;
    LAS float* hs = red + 512;
    const int tid = F.tid;
    for (int it = F.vcu; it < NB * 4 * 127 * 2; it += F.G) {
        const int which = it & 1; int r = it >> 1; const int n = r % 127; r /= 127; const int g = r & 3, b = r >> 2;
        const float* pe = which ? pe_v : pe_k; const float* w1 = which ? w1v : w1k; const float* w2 = which ? w2v : w2k;
        for (int i = tid; i < 2048; i += NTHREADS) { const int l = i >> 6, d = i & 63;
            xs[i] = bf2f(KV[(size_t)(b * T + 16 * n + l) * 1536 + which * 256 + g * 64 + d]) + pe[i]; }
        __syncthreads();
        { const int j = tid & 127, part = tid >> 7; float a = 0.f;
          for (int i = part * 512; i < part * 512 + 512; ++i) a += xs[i] * w1[(size_t)i * 128 + j];
          red[part * 128 + j] = a; }
        __syncthreads();
        if (tid < 128) hs[tid] = silu((red[tid] + red[128 + tid]) + (red[256 + tid] + red[384 + tid]));
        __syncthreads();
        if (tid < 64) { float o = 0.f; for (int j = 0; j < 128; ++j) o += hs[j] * w2[j * 64 + tid];
            bf16* dst = (bf16*)(F.ws + (which ? WS_VC : WS_KC)); dst[((size_t)(b * 4 + g) * 128 + n) * 64 + tid] = (bf16)f2bf(o); }
        __syncthreads();
    }
}

__device__ __forceinline__ float dot64_bf(const LAS float* qs, const bf16* kr) {
    float d = 0.f;
#pragma unroll
    for (int k8 = 0; k8 < 8; ++k8) { const v4u w = *(const v4u*)(kr + k8 * 8);
        d += qs[k8 * 8] * bflo(w.x) + qs[k8 * 8 + 1] * bfhi(w.x) + qs[k8 * 8 + 2] * bflo(w.y) + qs[k8 * 8 + 3] * bfhi(w.y)
           + qs[k8 * 8 + 4] * bflo(w.z) + qs[k8 * 8 + 5] * bfhi(w.z) + qs[k8 * 8 + 6] * bflo(w.w) + qs[k8 * 8 + 7] * bfhi(w.w); }
    return d;
}
__device__ __forceinline__ void nsa_naive(Frame& F) {
    bf16* QATT = (bf16*)(F.ws + WS_QATT); const bf16* KV = (const bf16*)(F.ws + WS_KV); const bf16* KC = (const bf16*)(F.ws + WS_KC); const bf16* VC = (const bf16*)(F.ws + WS_VC);
    const bf16* GATES = (const bf16*)(F.ws + WS_GATES);
    const int sub = F.tid >> 8, w = (F.tid >> 6) & 3, lane = F.lane;
    LAS float* base = (LAS float*)(F.lds + sub * 16384);
    LAS float* q_s = base;
    LAS float* p_s = base + 256;
    LAS float* pc_s = base + 256 + 2048;
    LAS float* imp_s = pc_s + 512;
    LAS int* sel_s = (LAS int*)(imp_s + 32);
    for (int it0 = F.vcu * 2; it0 < NB * T * 4; it0 += F.G * 2) {
        const int it = it0 + sub; const int g = it & 3, t = (it >> 2) & (T - 1), b = it >> 13;
        const int h = g * 4 + w;
        const float slope2 = __builtin_amdgcn_exp2f(-0.5f * (float)(h + 1)) * LOG2E;
        const size_t row = (size_t)(b * T + t);
        q_s[w * 64 + lane] = bf2f(QATT[row * 1024 + h * 64 + lane]);
        __syncthreads();
        float s0 = -INFINITY, s1 = -INFINITY;
        { const int n0 = lane, n1 = lane + 64; const bf16* kcb = KC + (size_t)(b * 4 + g) * 128 * 64;
          if (16 * n0 + 31 <= t) s0 = dot64_bf(q_s + w * 64, kcb + n0 * 64) - slope2 * ((float)t - (16.0f * n0 + 15.5f));
          if (n1 < 127 && 16 * n1 + 31 <= t) s1 = dot64_bf(q_s + w * 64, kcb + n1 * 64) - slope2 * ((float)t - (16.0f * n1 + 15.5f)); }
        float mm = wave_max(fmaxf(s0, s1));
        if (!(mm > -INFINITY)) mm = 0.f;
        float p0 = __builtin_amdgcn_exp2f(s0 - mm), p1 = __builtin_amdgcn_exp2f(s1 - mm);
        float dsum = wave_sum(p0 + p1);
        if (!(dsum > 0.f)) dsum = 1.f;
        p0 /= dsum; p1 /= dsum;
        pc_s[w * 128 + lane] = p0; pc_s[w * 128 + 64 + lane] = p1;
        __syncthreads();
        float o_cmp = 0.f;
        { const bf16* vcb = VC + (size_t)(b * 4 + g) * 128 * 64;
          for (int n = 0; n < 127; ++n) o_cmp += pc_s[w * 128 + n] * bf2f(vcb[n * 64 + lane]); }
        if ((F.tid & 255) < 32) { const int s = F.tid & 255; float im = 0.f;
            for (int n = 4 * s - 1; n <= 4 * s + 3; ++n) if (n >= 0 && n < 127) im += ((pc_s[n] + pc_s[128 + n]) + pc_s[256 + n]) + pc_s[384 + n];
            imp_s[s] = im; }
        __syncthreads();
        if ((F.tid & 255) == 0) { const int cur = t >> 6; unsigned used = 0u; int cnt = 0;
            for (int i = 0; i < 8; ++i) { float best = -INFINITY; int bi = -1;
                for (int s = 0; s < 32; ++s) { if ((used >> s) & 1u) continue; if (64 * s > t) continue;
                    const float sc = imp_s[s] + ((s == 0 || s == cur || s == cur - 1) ? 1.0e4f : 0.0f); if (sc > best) { best = sc; bi = s; } }
                if (bi >= 0) used |= 1u << bi;
                sel_s[i] = bi; } }
        __syncthreads();
        float o_slc = 0.f;
        { float mx = -INFINITY;
          for (int i = 0; i < 8; ++i) { const int sb = sel_s[i]; const int kp = 64 * sb + lane; float sc = -INFINITY;
              if (sb >= 0 && kp <= t) sc = dot64_bf(q_s + w * 64, KV + (size_t)(b * T + kp) * 1536 + 512 + g * 64) - slope2 * (float)(t - kp);
              p_s[w * 512 + i * 64 + lane] = sc; mx = fmaxf(mx, sc); }
          mx = wave_max(mx);
          float sum = 0.f;
          for (int i = 0; i < 8; ++i) { const float e = __builtin_amdgcn_exp2f(p_s[w * 512 + i * 64 + lane] - mx); p_s[w * 512 + i * 64 + lane] = e; sum += e; }
          sum = wave_sum(sum);
          __syncthreads();
          for (int i = 0; i < 8; ++i) { const int sb = sel_s[i]; if (sb < 0) continue;
              const bf16* vb = KV + (size_t)(b * T + 64 * sb) * 1536 + 768 + g * 64 + lane;
              for (int kk = 0; kk < 64; ++kk) o_slc += p_s[w * 512 + i * 64 + kk] * bf2f(vb[(size_t)kk * 1536]); }
          o_slc /= sum; }
        __syncthreads();
        float o_win = 0.f;
        { float mx = -INFINITY;
          for (int i = 0; i < 8; ++i) { const int kp = t - 511 + i * 64 + lane; float sc = -INFINITY;
              if (kp >= 0) sc = dot64_bf(q_s + w * 64, KV + (size_t)(b * T + kp) * 1536 + 1024 + g * 64) - slope2 * (float)(t - kp);
              p_s[w * 512 + i * 64 + lane] = sc; mx = fmaxf(mx, sc); }
          mx = wave_max(mx);
          float sum = 0.f;
          for (int i = 0; i < 8; ++i) { const float e = __builtin_amdgcn_exp2f(p_s[w * 512 + i * 64 + lane] - mx); p_s[w * 512 + i * 64 + lane] = e; sum += e; }
          sum = wave_sum(sum);
          __syncthreads();
          for (int i = 0; i < 512; ++i) { const int kp = t - 511 + i; if (kp >= 0) o_win += p_s[w * 512 + i] * bf2f(KV[(size_t)(b * T + kp) * 1536 + 1280 + g * 64 + lane]); }
          o_win /= sum; }
        const float g0 = bf2f(GATES[row * 64 + h * 3 + 0]), g1 = bf2f(GATES[row * 64 + h * 3 + 1]), g2 = bf2f(GATES[row * 64 + h * 3 + 2]);
        QATT[row * 1024 + h * 64 + lane] = (bf16)f2bf(g0 * o_cmp + g1 * o_slc + g2 * o_win);
        __syncthreads();
    }
}

__device__ __forceinline__ void xattn_naive(Frame& F) {
    const bf16* QX = (const bf16*)(F.ws + WS_QX); const bf16* KVM = (const bf16*)(F.ws + WS_KVM); bf16* OX = (bf16*)(F.ws + WS_OX);
    const int sub = F.tid >> 8, t8 = F.tid & 255, lane = F.lane, w = (F.tid >> 6) & 3;
    LAS float* base = (LAS float*)(F.lds + sub * 4096);
    LAS float* q_s = base; LAS float* p_s = base + 128; LAS float* red = base + 384;
    for (int it0 = F.vcu * 2; it0 < NB * T * 4; it0 += F.G * 2) {
        const int it = it0 + sub; const int h = it & 3, t = (it >> 2) & (T - 1), b = it >> 13;
        const size_t row = (size_t)(b * T + t);
        if (t8 < 128) q_s[t8] = bf2f(QX[row * 512 + h * 128 + t8]);
        __syncthreads();
        const bf16* kr = KVM + (size_t)(b * NMEM + t8) * 1024 + h * 128;
        const float s = dot64_bf(q_s, kr) + dot64_bf(q_s + 64, kr + 64);
        float mx = wave_max(s);
        if (lane == 0) red[w] = mx;
        __syncthreads();
        mx = fmaxf(fmaxf(red[0], red[1]), fmaxf(red[2], red[3]));
        __syncthreads();
        const float e = __builtin_amdgcn_exp2f(s - mx);
        p_s[t8] = e;
        float sum = wave_sum(e);
        if (lane == 0) red[w] = sum;
        __syncthreads();
        sum = (red[0] + red[1]) + (red[2] + red[3]);
        if (t8 < 128) { float acc = 0.f;
            for (int mmi = 0; mmi < 256; ++mmi) acc += p_s[mmi] * bf2f(KVM[(size_t)(b * NMEM + mmi) * 1024 + 512 + h * 128 + t8]);
            OX[row * 512 + h * 128 + t8] = (bf16)f2bf(acc / sum); }
        __syncthreads();
    }
}

namespace nsa {
constexpr int KS = 72, VS = 96;
constexpr int KT_BYTES = 64 * KS * 2, VT_BYTES = 64 * VS * 2;
constexpr int L_K = 0, L_V = 2 * KT_BYTES, L_IMP = L_V + 2 * VT_BYTES, L_SEL = L_IMP + 64 * 33 * 4, L_UNI = L_SEL + 256, L_END = L_UNI + 16;
constexpr float NEG = -1.0e30f;
typedef short v4i16_t __attribute__((ext_vector_type(4)));

__device__ __forceinline__ int crow(int r, int hi) { return (r & 3) + 8 * (r >> 2) + 4 * hi; }
__device__ __forceinline__ float xhalf_max(float m) { auto rr = __builtin_amdgcn_permlane32_swap(__float_as_uint(m), __float_as_uint(m), false, false); return fmaxf(__uint_as_float(rr[0]), __uint_as_float(rr[1])); }
__device__ __forceinline__ float xhalf_sum(float m) { auto rr = __builtin_amdgcn_permlane32_swap(__float_as_uint(m), __float_as_uint(m), false, false); return __uint_as_float(rr[0]) + __uint_as_float(rr[1]); }

struct TileRegs { v4u k, v; };
__device__ __forceinline__ TileRegs load_tile(const bf16* Kg, const bf16* Vg, int ld, int tid) {
    const int row = tid >> 3, ch = tid & 7; TileRegs r;
    r.k = *(const v4u*)(Kg + (size_t)row * ld + ch * 8); r.v = *(const v4u*)(Vg + (size_t)row * ld + ch * 8); return r;
}
__device__ __forceinline__ void store_tile(LAS unsigned char* lds, int buf, const TileRegs& r, int tid) {
    const int row = tid >> 3, ch = tid & 7;
    *(LAS v4u*)(lds + L_K + buf * KT_BYTES + (row * KS + ch * 8) * 2) = r.k;
    *(LAS v4u*)(lds + L_V + buf * VT_BYTES + (row * VS + ch * 8) * 2) = r.v;
}
__device__ __forceinline__ void qk_tile(f32x16& p0, f32x16& p1, const LAS unsigned char* Kt, const bf16x8 (&qf)[4], int r32, int hi, float i0, float i1) {
#pragma unroll
    for (int r = 0; r < 16; ++r) { p0[r] = i0; p1[r] = i1; }
#pragma unroll
    for (int ks = 0; ks < 4; ++ks) {
        const bf16x8 a0 = *(const LAS bf16x8*)(Kt + (r32 * KS + 16 * ks + 8 * hi) * 2);
        const bf16x8 a1 = *(const LAS bf16x8*)(Kt + ((32 + r32) * KS + 16 * ks + 8 * hi) * 2);
        p0 = __builtin_amdgcn_mfma_f32_32x32x16_bf16(a0, qf[ks], p0, 0, 0, 0);
        p1 = __builtin_amdgcn_mfma_f32_32x32x16_bf16(a1, qf[ks], p1, 0, 0, 0);
    }
}
__device__ __forceinline__ bf16x8 pack_p(const f32x16& p, int s) {
    v4u w; w.x = pk2(p[8 * s + 0], p[8 * s + 1]); w.y = pk2(p[8 * s + 2], p[8 * s + 3]); w.z = pk2(p[8 * s + 4], p[8 * s + 5]); w.w = pk2(p[8 * s + 6], p[8 * s + 7]);
    return __builtin_bit_cast(bf16x8, w);
}
__device__ __forceinline__ s16x4 tr_read(const LAS unsigned char* p) { return __builtin_bit_cast(s16x4, __builtin_amdgcn_ds_read_tr16_b64_v4i16((LAS v4i16_t*)p)); }
template <int NDB>
__device__ __forceinline__ void pv_tile(f32x16 (&o)[NDB], const LAS unsigned char* Vt, int vstride, const f32x16& p0, const f32x16& p1, int lane) {
    const int hi = lane >> 5, i16 = lane & 15, g1 = (lane >> 4) & 1;
    const LAS unsigned char* vb = Vt + ((4 * hi + (i16 >> 2)) * vstride + 16 * g1 + 4 * (i16 & 3)) * 2;
#pragma unroll
    for (int half = 0; half < 2; ++half)
#pragma unroll
        for (int s = 0; s < 2; ++s) {
            const bf16x8 pf = pack_p(half ? p1 : p0, s);
#pragma unroll
            for (int db = 0; db < NDB; ++db) {
                const LAS unsigned char* a = vb + ((32 * half + 16 * s) * vstride + 32 * db) * 2;
                const s16x4 lo = tr_read(a), hi4 = tr_read(a + 8 * vstride * 2);
                const bf16x8 vf = (bf16x8){lo[0], lo[1], lo[2], lo[3], hi4[0], hi4[1], hi4[2], hi4[3]};
                o[db] = __builtin_amdgcn_mfma_f32_32x32x16_bf16(vf, pf, o[db], 0, 0, 0);
            }
        }
}
__device__ __forceinline__ void softmax_step(f32x16& p0, f32x16& p1, float& m, float& l, f32x16 (&o)[2]) {
    float a = fmaxf(p0[0], p1[0]);
#pragma unroll
    for (int r = 1; r < 16; ++r) a = fmaxf(a, fmaxf(p0[r], p1[r]));
    a = xhalf_max(a);
    const float mn = fmaxf(m, a), alpha = __builtin_amdgcn_exp2f(m - mn);
    float s = 0.f;
#pragma unroll
    for (int r = 0; r < 16; ++r) { p0[r] = __builtin_amdgcn_exp2f(p0[r] - mn); p1[r] = __builtin_amdgcn_exp2f(p1[r] - mn); s += p0[r] + p1[r]; }
    s = xhalf_sum(s);
    l = l * alpha + s; m = mn;
#pragma unroll
    for (int r = 0; r < 16; ++r) { o[0][r] *= alpha; o[1][r] *= alpha; }
}


constexpr int K2_BYTES = 128 * KS * 2, V2_BYTES = 128 * VS * 2;
constexpr int YROW = 136;
constexpr int M_K = 0, M_V = 2 * K2_BYTES, M_IMP = M_V + 2 * V2_BYTES, M_SEL = M_IMP + 64 * 33 * 4, M_UNI = M_SEL + 256, M_Y = M_UNI + 16, M_END = M_Y + 8 * 32 * YROW;
static_assert(M_END <= RING_BYTES, "nsa LDS");
__device__ __forceinline__ TileRegs load1(const bf16* Kg, const bf16* Vg, int ld, int r0, int tid) {
    const int row = tid >> 3, ch = tid & 7; TileRegs r;
    if (r0 >= 0) { r.k = *(const v4u*)(Kg + (size_t)(r0 + row) * ld + ch * 8); r.v = *(const v4u*)(Vg + (size_t)(r0 + row) * ld + ch * 8); }
    else { r.k = (v4u){0u, 0u, 0u, 0u}; r.v = (v4u){0u, 0u, 0u, 0u}; }
    return r;
}
__device__ __forceinline__ void store1(LAS unsigned char* lds, int buf, int half, const TileRegs& r, int tid) {
    const int row = 64 * half + (tid >> 3), ch = tid & 7;
    *(LAS v4u*)(lds + M_K + buf * K2_BYTES + (row * KS + ch * 8) * 2) = r.k;
    *(LAS v4u*)(lds + M_V + buf * V2_BYTES + (row * VS + ch * 8) * 2) = r.v;
}
__device__ __forceinline__ void bias_mask(f32x16& p0, f32x16& p1, int mode, int qq, int hi, float slope2) {
    if (mode == 0) {
#pragma unroll
        for (int r = 0; r < 16; ++r) { p0[r] = fmaf(slope2, (float)crow(r, 0), p0[r]); p1[r] = fmaf(slope2, (float)crow(r, 0), p1[r]); }
    } else {
        int thr = qq - 4 * hi; asm volatile("" : "+v"(thr));
        if (mode == 1) {
#pragma unroll
            for (int r = 0; r < 16; ++r) { p0[r] = (crow(r, 0) <= thr) ? fmaf(slope2, (float)crow(r, 0), p0[r]) : NEG; p1[r] = (crow(r, 0) + 32 <= thr) ? fmaf(slope2, (float)crow(r, 0), p1[r]) : NEG; }
        } else {
#pragma unroll
            for (int r = 0; r < 16; ++r) { p0[r] = (crow(r, 0) > thr) ? fmaf(slope2, (float)crow(r, 0), p0[r]) : NEG; p1[r] = (crow(r, 0) + 32 > thr) ? fmaf(slope2, (float)crow(r, 0), p1[r]) : NEG; }
        }
    }
}
__device__ __forceinline__ void block_step(LAS unsigned char* lds, int buf, int half, const bf16x8 (&qf)[4], int j, int mode, bool sel,
                                           int t, int qq, int r32, int hi, int lane, float slope2, float sl4h, float& m, float& l, f32x16 (&o)[2]) {
    if (mode == 3) return;
    if (__builtin_amdgcn_ballot_w64(sel) == 0ull) return;
    const float bj = sl4h - slope2 * (float)(t - 64 * j) + (sel ? 0.f : NEG);
    f32x16 p0, p1;
    qk_tile(p0, p1, lds + M_K + buf * K2_BYTES + half * 64 * KS * 2, qf, r32, hi, bj, bj + 32.0f * slope2);
    bias_mask(p0, p1, mode, qq, hi, slope2);
    softmax_step(p0, p1, m, l, o);
    pv_tile<2>(o, lds + M_V + buf * V2_BYTES + half * 64 * VS * 2, VS, p0, p1, lane);
}

__device__ __forceinline__ void unit(Frame& F, int b, int g, int qb) {
    LAS unsigned char* lds = F.lds;
    const int tid = F.tid, lane = F.lane, w = F.wave, hg = w >> 1, qh = w & 1, r32 = lane & 31, hi = lane >> 5;
    const int h = g * 4 + hg, qq = qh * 32 + r32, t = 64 * qb + qq;
    const size_t row = (size_t)b * T + t;
    const bf16* QATT = (const bf16*)(F.ws + WS_QATT); bf16* YA = (bf16*)(F.ws + WS_YA); const bf16* KV = (const bf16*)(F.ws + WS_KV);
    const float slope2 = __builtin_amdgcn_exp2f(-0.5f * (float)(h + 1)) * LOG2E;
    bf16x8 qf[4];
#pragma unroll
    for (int ks = 0; ks < 4; ++ks) qf[ks] = *(const bf16x8*)(QATT + row * 1024 + h * 64 + 16 * ks + 8 * hi);
    const float sl4h = slope2 * (float)(4 * hi);
    const bf16* GATES = (const bf16*)(F.ws + WS_GATES);
    const float g0 = bf2f(GATES[row * 64 + h * 3 + 0]), g1 = bf2f(GATES[row * 64 + h * 3 + 1]), g2 = bf2f(GATES[row * 64 + h * 3 + 2]);
    LAS float* impL = (LAS float*)(lds + M_IMP);
    for (int i = tid; i < 64 * 33; i += NTHREADS) impL[i] = 0.f;
    LAS unsigned char* yl = lds + M_Y + (w * 32 + r32) * YROW + 8 * hi;
    {
        const bf16* KC = (const bf16*)(F.ws + WS_KC) + (size_t)(b * 4 + g) * 128 * 64; const bf16* VC = (const bf16*)(F.ws + WS_VC) + (size_t)(b * 4 + g) * 128 * 64;
        { const TileRegs ta = load1(KC, VC, 64, 0, tid), tb = load1(KC, VC, 64, 64, tid); store1(lds, 0, 0, ta, tid); store1(lds, 0, 1, tb, tid); }
        __syncthreads();
        const float cj = slope2 * ((float)t - 15.5f), sl16 = 16.0f * slope2;
        const float b0 = 16.0f * sl4h - cj;
        int nthr = ((t - 31) >> 4) - 4 * hi; asm volatile("" : "+v"(nthr));
        float m = NEG, l = 0.f;
#pragma unroll 1
        for (int blk = 0; blk < 2; ++blk) {
            f32x16 p0, p1; const float bi = b0 + (float)(1024 * blk) * slope2;
            qk_tile(p0, p1, lds + M_K + blk * 64 * KS * 2, qf, r32, hi, bi, bi + 512.0f * slope2);
            float a = NEG;
#pragma unroll
            for (int r = 0; r < 16; ++r) { const int c0 = 64 * blk + crow(r, 0), c1 = c0 + 32;
                p0[r] = (c0 <= nthr) ? fmaf(sl16, (float)crow(r, 0), p0[r]) : NEG;
                p1[r] = (c1 <= nthr) ? fmaf(sl16, (float)crow(r, 0), p1[r]) : NEG;
                a = fmaxf(a, fmaxf(p0[r], p1[r])); }
            a = xhalf_max(a);
            const float mn = fmaxf(m, a); float sacc = 0.f;
#pragma unroll
            for (int r = 0; r < 16; ++r) { const int c0 = 64 * blk + crow(r, 0), c1 = c0 + 32;
                sacc += ((c0 <= nthr) ? __builtin_amdgcn_exp2f(p0[r] - mn) : 0.f) + ((c1 <= nthr) ? __builtin_amdgcn_exp2f(p1[r] - mn) : 0.f); }
            l = l * __builtin_amdgcn_exp2f(m - mn) + xhalf_sum(sacc); m = mn;
        }
        const float inv = (l > 0.f) ? 1.0f / l : 0.f;
        f32x16 o[2];
#pragma unroll
        for (int r = 0; r < 16; ++r) { o[0][r] = 0.f; o[1][r] = 0.f; }
#pragma unroll 1
        for (int blk = 0; blk < 2; ++blk) {
            f32x16 p0, p1; const float bi = b0 + (float)(1024 * blk) * slope2;
            qk_tile(p0, p1, lds + M_K + blk * 64 * KS * 2, qf, r32, hi, bi, bi + 512.0f * slope2);
#pragma unroll
            for (int r = 0; r < 16; ++r) { const int c0 = 64 * blk + crow(r, 0), c1 = c0 + 32;
                p0[r] = (c0 <= nthr) ? __builtin_amdgcn_exp2f(fmaf(sl16, (float)crow(r, 0), p0[r]) - m) * inv : 0.f;
                p1[r] = (c1 <= nthr) ? __builtin_amdgcn_exp2f(fmaf(sl16, (float)crow(r, 0), p1[r]) - m) * inv : 0.f; }
#pragma unroll
            for (int i = 0; i < 4; ++i) {
                const int s0 = 16 * blk + 2 * i + hi, s1 = s0 + 8;
                __hip_atomic_fetch_add(&impL[qq * 33 + s0], (p0[4 * i] + p0[4 * i + 1]) + (p0[4 * i + 2] + p0[4 * i + 3]), __ATOMIC_RELAXED, __HIP_MEMORY_SCOPE_WORKGROUP);
                __hip_atomic_fetch_add(&impL[qq * 33 + s0 + 1], p0[4 * i + 3], __ATOMIC_RELAXED, __HIP_MEMORY_SCOPE_WORKGROUP);
                __hip_atomic_fetch_add(&impL[qq * 33 + s1], (p1[4 * i] + p1[4 * i + 1]) + (p1[4 * i + 2] + p1[4 * i + 3]), __ATOMIC_RELAXED, __HIP_MEMORY_SCOPE_WORKGROUP);
                if (s1 + 1 < 32) __hip_atomic_fetch_add(&impL[qq * 33 + s1 + 1], p1[4 * i + 3], __ATOMIC_RELAXED, __HIP_MEMORY_SCOPE_WORKGROUP);
            }
            pv_tile<2>(o, lds + M_V + blk * 64 * VS * 2, VS, p0, p1, lane);
        }
#pragma unroll
        for (int db = 0; db < 2; ++db)
#pragma unroll
            for (int i = 0; i < 4; ++i) { v2u wv; wv.x = pk2(o[db][4 * i] * g0, o[db][4 * i + 1] * g0); wv.y = pk2(o[db][4 * i + 2] * g0, o[db][4 * i + 3] * g0); *(LAS v2u*)(yl + 64 * db + 16 * i) = wv; }
    }
    __syncthreads();
    if (w == 0) {
        unsigned mask;
        if (qb <= 7) mask = (2u << qb) - 1u;
        else {
            float v0 = -1.f, v1 = -1.f, v2 = -1.f, v3 = -1.f, v4 = -1.f; int i0 = 0, i1 = 0, i2 = 0, i3 = 0, i4 = 0;
#pragma unroll
            for (int c0 = 1; c0 < 31; c0 += 6) {
                float xv[6];
#pragma unroll
                for (int e = 0; e < 6; ++e) { const int sx = c0 + e; xv[e] = (sx < 31) ? impL[lane * 33 + sx] : -1.f; }
#pragma unroll
                for (int e = 0; e < 6; ++e) { const int sx = c0 + e; if (sx < 31) {
                    const float x = (sx <= qb - 2) ? xv[e] : -1.f;
                    bool c = x > v4; v4 = c ? x : v4; i4 = c ? sx : i4;
                    c = v4 > v3; { const float tv = c ? v4 : v3; v4 = c ? v3 : v4; v3 = tv; const int ti = c ? i4 : i3; i4 = c ? i3 : i4; i3 = ti; }
                    c = v3 > v2; { const float tv = c ? v3 : v2; v3 = c ? v2 : v3; v2 = tv; const int ti = c ? i3 : i2; i3 = c ? i2 : i3; i2 = ti; }
                    c = v2 > v1; { const float tv = c ? v2 : v1; v2 = c ? v1 : v2; v1 = tv; const int ti = c ? i2 : i1; i2 = c ? i1 : i2; i1 = ti; }
                    c = v1 > v0; { const float tv = c ? v1 : v0; v1 = c ? v0 : v1; v0 = tv; const int ti = c ? i1 : i0; i1 = c ? i0 : i1; i0 = ti; } } }
                asm volatile("" ::: "memory");
            }
            mask = 1u | (1u << qb) | (1u << (qb - 1)) | (1u << i0) | (1u << i1) | (1u << i2) | (1u << i3) | (1u << i4);
        }
        ((LAS unsigned*)(lds + M_SEL))[lane] = mask;
        unsigned un = mask;
#pragma unroll
        for (int o = 1; o < 64; o <<= 1) un |= (unsigned)__shfl_xor((int)un, o);
        if (lane == 0) *(LAS unsigned*)(lds + M_UNI) = un;
    }
    __syncthreads();
    const unsigned selm = ((const LAS unsigned*)(lds + M_SEL))[qq];
    const unsigned uni = *(const LAS unsigned*)(lds + M_UNI);
    { const bf16* qp = QATT + row * 1024 + h * 64 + 8 * hi; asm volatile("" : "+v"(qp));
#pragma unroll
      for (int ks = 0; ks < 4; ++ks) qf[ks] = *(const bf16x8*)(qp + 16 * ks); }
    {
        float m = NEG, l = 0.f; f32x16 o[2];
#pragma unroll
        for (int r = 0; r < 16; ++r) { o[0][r] = 0.f; o[1][r] = 0.f; }
        const bf16* Kb = KV + (size_t)b * T * 1536 + 512 + g * 64; const bf16* Vb = KV + (size_t)b * T * 1536 + 768 + g * 64;
        unsigned rem = uni;
        int ja = __builtin_ctz(rem); rem &= rem - 1u; int jb = rem ? __builtin_ctz(rem) : -1; if (rem) rem &= rem - 1u;
        int buf = 0;
        { const TileRegs ta = load1(Kb, Vb, 1536, 64 * ja, tid), tb = load1(Kb, Vb, 1536, jb < 0 ? -1 : 64 * jb, tid); store1(lds, 0, 0, ta, tid); store1(lds, 0, 1, tb, tid); }
        __syncthreads();
        for (;;) {
            const bool has_next = rem != 0u; int na = 0, nb = -1; TileRegs tr;
            if (has_next) { na = __builtin_ctz(rem); rem &= rem - 1u; nb = rem ? __builtin_ctz(rem) : -1; if (rem) rem &= rem - 1u;
                tr = load1(Kb, Vb, 1536, 64 * na, tid); }
            block_step(lds, buf, 0, qf, ja, (ja == qb) ? 1 : 0, (selm >> ja) & 1u, t, qq, r32, hi, lane, slope2, sl4h, m, l, o);
            if (has_next) { store1(lds, buf ^ 1, 0, tr, tid); tr = load1(Kb, Vb, 1536, nb < 0 ? -1 : 64 * nb, tid); }
            block_step(lds, buf, 1, qf, jb, (jb < 0) ? 3 : ((jb == qb) ? 1 : 0), (jb >= 0) && ((selm >> jb) & 1u), t, qq, r32, hi, lane, slope2, sl4h, m, l, o);
            if (has_next) store1(lds, buf ^ 1, 1, tr, tid);
            __syncthreads();
            if (!has_next) break;
            buf ^= 1; ja = na; jb = nb;
        }
        const float sc = g1 / l;
#pragma unroll
        for (int db = 0; db < 2; ++db)
#pragma unroll
            for (int i = 0; i < 4; ++i) { const v2u pv = *(const LAS v2u*)(yl + 64 * db + 16 * i); v2u wv;
                wv.x = pk2(bflo(pv.x) + o[db][4 * i] * sc, bfhi(pv.x) + o[db][4 * i + 1] * sc); wv.y = pk2(bflo(pv.y) + o[db][4 * i + 2] * sc, bfhi(pv.y) + o[db][4 * i + 3] * sc); *(LAS v2u*)(yl + 64 * db + 16 * i) = wv; }
    }
    {
        float m = NEG, l = 0.f; f32x16 o[2];
#pragma unroll
        for (int r = 0; r < 16; ++r) { o[0][r] = 0.f; o[1][r] = 0.f; }
        const bf16* Kb = KV + (size_t)b * T * 1536 + 1024 + g * 64; const bf16* Vb = KV + (size_t)b * T * 1536 + 1280 + g * 64;
        const int jlast = (qb >= 8) ? qb - 8 : 0;
        int ja = qb, jb = (qb - 1 >= jlast) ? qb - 1 : -1, buf = 0;
        { const TileRegs ta = load1(Kb, Vb, 1536, 64 * ja, tid), tb = load1(Kb, Vb, 1536, jb < 0 ? -1 : 64 * jb, tid); store1(lds, 0, 0, ta, tid); store1(lds, 0, 1, tb, tid); }
        __syncthreads();
        for (;;) {
            const int na = ja - 2; const bool has_next = (jb >= 0) && (na >= jlast); const int nb = (na - 1 >= jlast) ? na - 1 : -1; TileRegs tr;
            if (has_next) tr = load1(Kb, Vb, 1536, 64 * na, tid);
            block_step(lds, buf, 0, qf, ja, (ja == qb) ? 1 : ((ja == qb - 8) ? 2 : 0), true, t, qq, r32, hi, lane, slope2, sl4h, m, l, o);
            if (has_next) { store1(lds, buf ^ 1, 0, tr, tid); tr = load1(Kb, Vb, 1536, nb < 0 ? -1 : 64 * nb, tid); }
            block_step(lds, buf, 1, qf, jb, (jb < 0) ? 3 : ((jb == qb - 8) ? 2 : 0), jb >= 0, t, qq, r32, hi, lane, slope2, sl4h, m, l, o);
            if (has_next) store1(lds, buf ^ 1, 1, tr, tid);
            __syncthreads();
            if (!has_next) break;
            buf ^= 1; ja = na; jb = nb;
        }
        const float sc = g2 / l;
#pragma unroll
        for (int db = 0; db < 2; ++db)
#pragma unroll
            for (int i = 0; i < 4; ++i) { const v2u pv = *(const LAS v2u*)(yl + 64 * db + 16 * i); v2u wv;
                wv.x = pk2(bflo(pv.x) + o[db][4 * i] * sc, bfhi(pv.x) + o[db][4 * i + 1] * sc); wv.y = pk2(bflo(pv.y) + o[db][4 * i + 2] * sc, bfhi(pv.y) + o[db][4 * i + 3] * sc);
                *(v2u*)(YA + row * 1024 + h * 64 + 32 * db + 8 * i + 4 * hi) = wv; }
    }
}

__device__ __forceinline__ void phase(Frame& F) {
    for (int u = F.vcu; u < 1024; u += F.G) {
        const int slot = u >> 8, c = u & 255, bg = c >> 3, j = c & 7;
        const int qb = (slot == 0) ? 31 - j : (slot == 1) ? 16 + j : (slot == 2) ? 15 - j : j;
        unit(F, bg >> 2, bg & 3, qb);
        __syncthreads();
    }
}
}

namespace xat {
constexpr int KS = 136, VS = 160;
constexpr int KT_BYTES = 64 * KS * 2, VT_BYTES = 64 * VS * 2;
constexpr int L_K = 0, L_V = 2 * KT_BYTES;
struct TileRegs { v4u k[2], v[2]; };
__device__ __forceinline__ TileRegs load_tile(const bf16* Kg, const bf16* Vg, int tid) {
    const int row = tid >> 3, ch = tid & 7; TileRegs r;
    r.k[0] = *(const v4u*)(Kg + (size_t)row * 1024 + ch * 8); r.k[1] = *(const v4u*)(Kg + (size_t)row * 1024 + 64 + ch * 8);
    r.v[0] = *(const v4u*)(Vg + (size_t)row * 1024 + ch * 8); r.v[1] = *(const v4u*)(Vg + (size_t)row * 1024 + 64 + ch * 8); return r;
}
__device__ __forceinline__ void store_tile(LAS unsigned char* lds, int buf, const TileRegs& r, int tid) {
    const int row = tid >> 3, ch = tid & 7;
    *(LAS v4u*)(lds + L_K + buf * KT_BYTES + (row * KS + ch * 8) * 2) = r.k[0]; *(LAS v4u*)(lds + L_K + buf * KT_BYTES + (row * KS + 64 + ch * 8) * 2) = r.k[1];
    *(LAS v4u*)(lds + L_V + buf * VT_BYTES + (row * VS + ch * 8) * 2) = r.v[0]; *(LAS v4u*)(lds + L_V + buf * VT_BYTES + (row * VS + 64 + ch * 8) * 2) = r.v[1];
}
__device__ __forceinline__ void unit(Frame& F, int b, int hx, int qblk) {
    LAS unsigned char* lds = F.lds;
    const int tid = F.tid, lane = F.lane, w = F.wave, r32 = lane & 31, hi = lane >> 5;
    const size_t row = (size_t)b * T + qblk * 256 + w * 32 + r32;
    const bf16* QX = (const bf16*)(F.ws + WS_QX); const bf16* KVM = (const bf16*)(F.ws + WS_KVM) + (size_t)b * NMEM * 1024 + hx * 128; bf16* OX = (bf16*)(F.ws + WS_OX);
    bf16x8 qf[8];
#pragma unroll
    for (int ks = 0; ks < 8; ++ks) qf[ks] = *(const bf16x8*)(QX + row * 512 + hx * 128 + 16 * ks + 8 * hi);
    float m = nsa::NEG, l = 0.f; f32x16 o[4];
#pragma unroll
    for (int db = 0; db < 4; ++db)
#pragma unroll
        for (int r = 0; r < 16; ++r) o[db][r] = 0.f;
    { const TileRegs tr = load_tile(KVM, KVM + 512, tid); store_tile(lds, 0, tr, tid); }
    __syncthreads();
    int buf = 0;
#pragma unroll 1
    for (int j = 0; j < 4; ++j) {
        const bool has_next = j < 3; TileRegs tr;
        if (has_next) tr = load_tile(KVM + (size_t)(64 * (j + 1)) * 1024, KVM + (size_t)(64 * (j + 1)) * 1024 + 512, tid);
        f32x16 p0, p1;
#pragma unroll
        for (int r = 0; r < 16; ++r) { p0[r] = 0.f; p1[r] = 0.f; }
        const LAS unsigned char* Kt = lds + L_K + buf * KT_BYTES;
#pragma unroll
        for (int ks = 0; ks < 8; ++ks) {
            const bf16x8 a0 = *(const LAS bf16x8*)(Kt + (r32 * KS + 16 * ks + 8 * hi) * 2);
            const bf16x8 a1 = *(const LAS bf16x8*)(Kt + ((32 + r32) * KS + 16 * ks + 8 * hi) * 2);
            p0 = __builtin_amdgcn_mfma_f32_32x32x16_bf16(a0, qf[ks], p0, 0, 0, 0);
            p1 = __builtin_amdgcn_mfma_f32_32x32x16_bf16(a1, qf[ks], p1, 0, 0, 0);
        }
        float a = fmaxf(p0[0], p1[0]);
#pragma unroll
        for (int r = 1; r < 16; ++r) a = fmaxf(a, fmaxf(p0[r], p1[r]));
        a = nsa::xhalf_max(a);
        const float mn = fmaxf(m, a), alpha = __builtin_amdgcn_exp2f(m - mn);
        float s = 0.f;
#pragma unroll
        for (int r = 0; r < 16; ++r) { p0[r] = __builtin_amdgcn_exp2f(p0[r] - mn); p1[r] = __builtin_amdgcn_exp2f(p1[r] - mn); s += p0[r] + p1[r]; }
        s = nsa::xhalf_sum(s);
        l = l * alpha + s; m = mn;
#pragma unroll
        for (int db = 0; db < 4; ++db)
#pragma unroll
            for (int r = 0; r < 16; ++r) o[db][r] *= alpha;
        nsa::pv_tile<4>(o, lds + L_V + buf * VT_BYTES, VS, p0, p1, lane);
        if (has_next) store_tile(lds, buf ^ 1, tr, tid);
        __syncthreads();
        buf ^= 1;
    }
    const float inv = 1.0f / l;
#pragma unroll
    for (int db = 0; db < 4; ++db)
#pragma unroll
        for (int i = 0; i < 4; ++i) { v2u wv; wv.x = pk2(o[db][4 * i] * inv, o[db][4 * i + 1] * inv); wv.y = pk2(o[db][4 * i + 2] * inv, o[db][4 * i + 3] * inv);
            *(v2u*)(OX + row * 512 + hx * 128 + 32 * db + 8 * i + 4 * hi) = wv; }
}
__device__ __forceinline__ void phase(Frame& F) {
    for (int u = F.vcu; u < NB * 4 * 8; u += F.G) { unit(F, u >> 5, (u >> 3) & 3, u & 7); __syncthreads(); }
}
}

namespace hg {
constexpr int QS = 136, TS = 160;
constexpr int L_QD = 0, L_KD = L_QD + 64 * QS * 2, L_KE = L_KD + 64 * QS * 2, L_V = L_KE + 64 * TS * 2, L_S = L_V + 64 * TS * 2, L_TOT = L_S + 128 * TS * 2,
              L_BLAST = L_TOT + 8 * 128 * 4, L_SSQ = L_BLAST + 128 * 4, L_GN = L_SSQ + 4 * 64 * 4, L_END = L_GN + 128 * 4;
static_assert(L_END <= RING_BYTES, "hgrn LDS");
struct Raw { unsigned q[8], f[8], v[8]; };
__device__ __forceinline__ Raw load_raw(const bf16* QA, const half_t* LOGF, const bf16* IB, size_t base, int n, int w, int lane) {
    Raw r;
#pragma unroll
    for (int i = 0; i < 8; ++i) { const size_t o = base + (size_t)(n * 64 + 8 * w + i) * 1024 + 2 * lane;
        r.q[i] = *(const unsigned*)(QA + o); r.f[i] = *(const unsigned*)(LOGF + o); r.v[i] = *(const unsigned*)(IB + o); }
    return r;
}
__device__ __forceinline__ bf16x8 tr_frag(const LAS unsigned char* tile, int stride, int R0, int C0, int rstep, int lane) {
    const int i16 = lane & 15, g1 = (lane >> 4) & 1;
    const LAS unsigned char* a = tile + ((R0 + (i16 >> 2)) * stride + C0 + 16 * g1 + 4 * (i16 & 3)) * 2;
    const s16x4 lo = nsa::tr_read(a), hi4 = nsa::tr_read(a + rstep * stride * 2);
    return (bf16x8){lo[0], lo[1], lo[2], lo[3], hi4[0], hi4[1], hi4[2], hi4[3]};
}
template <bool STORE>
__device__ __forceinline__ void unit(Frame& F, int b, int h, const float* g_norm) {
    LAS unsigned char* lds = F.lds;
    const int tid = F.tid, lane = F.lane, w = F.wave, r32 = lane & 31, hi = lane >> 5, cb = w & 1, vb = w >> 1;
    bf16* QA = (bf16*)(F.ws + WS_QA); const half_t* LOGF = (const half_t*)(F.ws + WS_LOGF); const bf16* IB = (const bf16*)(F.ws + WS_I);
    LAS float* totL = (LAS float*)(lds + L_TOT); LAS float* blastL = (LAS float*)(lds + L_BLAST); LAS float* ssqL = (LAS float*)(lds + L_SSQ); LAS float* gnL = (LAS float*)(lds + L_GN);
    for (int i = tid; i < 128 * TS * 2 / 4; i += NTHREADS) ((LAS unsigned*)(lds + L_S))[i] = 0u;
    if (tid < 128) gnL[tid] = g_norm[tid];
    f32x16 S0, S1;
#pragma unroll
    for (int r = 0; r < 16; ++r) { S0[r] = 0.f; S1[r] = 0.f; }
    const size_t base = (size_t)b * T * 1024 + h * 128;
    Raw nxt = load_raw(QA, LOGF, IB, base, 0, w, lane);
#pragma unroll 1
    for (int n = 0; n < 32; ++n) {
        const Raw cur = nxt;
        typedef _Float16 h2 __attribute__((ext_vector_type(2)));
        typedef float f2 __attribute__((ext_vector_type(2)));
        float bl0[8], bl1[8]; float s0 = 0.f, s1 = 0.f;
#pragma unroll
        for (int i = 0; i < 8; ++i) { const h2 lh = __builtin_bit_cast(h2, cur.f[i]); s0 += (float)lh[0]; s1 += (float)lh[1]; bl0[i] = s0; bl1[i] = s1; }
        *(LAS f2*)(totL + w * 128 + 2 * lane) = (f2){s0, s1};
        __syncthreads();
        if (n + 1 < 32) nxt = load_raw(QA, LOGF, IB, base, n + 1, w, lane);
        float off0 = 0.f, off1 = 0.f, all0 = 0.f, all1 = 0.f;
#pragma unroll
        for (int ww = 0; ww < 8; ++ww) { const f2 tt = *(const LAS f2*)(totL + ww * 128 + 2 * lane); all0 += tt[0]; all1 += tt[1]; if (ww < w) { off0 += tt[0]; off1 += tt[1]; } }
        if (w == 0) *(LAS f2*)(blastL + 2 * lane) = (f2){all0, all1};
#pragma unroll
        for (int i = 0; i < 8; ++i) {
            const int rowl = 8 * w + i;
            const h2 lh = __builtin_bit_cast(h2, cur.f[i]);
            const float l0 = (float)lh[0], l1 = (float)lh[1];
            const float k0 = 1.0f - __builtin_amdgcn_exp2f(l0), k1 = 1.0f - __builtin_amdgcn_exp2f(l1);
            const float b0 = off0 + bl0[i], b1 = off1 + bl1[i];
            const float q0 = bflo(cur.q[i]), q1 = bfhi(cur.q[i]);
            *(LAS unsigned*)(lds + L_QD + (rowl * QS + 2 * lane) * 2) = pk2(q0 * __builtin_amdgcn_exp2f(b0), q1 * __builtin_amdgcn_exp2f(b1));
            *(LAS unsigned*)(lds + L_KD + (rowl * QS + 2 * lane) * 2) = pk2(k0 * __builtin_amdgcn_exp2f(-b0), k1 * __builtin_amdgcn_exp2f(-b1));
            *(LAS unsigned*)(lds + L_KE + (rowl * TS + 2 * lane) * 2) = pk2(k0 * __builtin_amdgcn_exp2f(all0 - b0), k1 * __builtin_amdgcn_exp2f(all1 - b1));
            *(LAS unsigned*)(lds + L_V + (rowl * TS + 2 * lane) * 2) = cur.v[i];
        }
        __syncthreads();
        bf16x8 bq[8];
#pragma unroll
        for (int ks = 0; ks < 8; ++ks) bq[ks] = *(const LAS bf16x8*)(lds + L_QD + ((32 * cb + r32) * QS + 16 * ks + 8 * hi) * 2);
        f32x16 O;
#pragma unroll
        for (int r = 0; r < 16; ++r) O[r] = 0.f;
#pragma unroll
        for (int sb = 0; sb < 2; ++sb) {
            if (sb <= cb) {
                f32x16 P;
#pragma unroll
                for (int r = 0; r < 16; ++r) P[r] = 0.f;
#pragma unroll
                for (int ks = 0; ks < 8; ++ks) { const bf16x8 a = *(const LAS bf16x8*)(lds + L_KD + ((32 * sb + r32) * QS + 16 * ks + 8 * hi) * 2);
                    P = __builtin_amdgcn_mfma_f32_32x32x16_bf16(a, bq[ks], P, 0, 0, 0); }
                if (sb == cb) {
#pragma unroll
                    for (int r = 0; r < 16; ++r) if (nsa::crow(r, hi) > r32) P[r] = 0.f;
                }
#pragma unroll
                for (int s = 0; s < 2; ++s) {
                    const bf16x8 pf = nsa::pack_p(P, s);
                    const bf16x8 vf = tr_frag(lds + L_V, TS, 32 * sb + 16 * s + 4 * hi, 32 * vb, 8, lane);
                    O = __builtin_amdgcn_mfma_f32_32x32x16_bf16(vf, pf, O, 0, 0, 0);
                }
            }
        }
#pragma unroll
        for (int ks = 0; ks < 8; ++ks) { const bf16x8 sf = tr_frag(lds + L_S, TS, 16 * ks + 8 * hi, 32 * vb, 4, lane);
            O = __builtin_amdgcn_mfma_f32_32x32x16_bf16(sf, bq[ks], O, 0, 0, 0); }
        { float q = 0.f;
#pragma unroll
          for (int r = 0; r < 16; ++r) q += O[r] * O[r];
          q = nsa::xhalf_sum(q);
          if (hi == 0) ssqL[vb * 64 + 32 * cb + r32] = q; }
        { const float d0 = __builtin_amdgcn_exp2f(blastL[64 * cb + r32]), d1 = __builtin_amdgcn_exp2f(blastL[64 * cb + 32 + r32]);
#pragma unroll
          for (int r = 0; r < 16; ++r) { S0[r] *= d0; S1[r] *= d1; }
#pragma unroll
          for (int ss = 0; ss < 4; ++ss) {
              const bf16x8 vf = tr_frag(lds + L_V, TS, 16 * ss + 8 * hi, 32 * vb, 4, lane);
              const bf16x8 k0f = tr_frag(lds + L_KE, TS, 16 * ss + 8 * hi, 64 * cb, 4, lane);
              const bf16x8 k1f = tr_frag(lds + L_KE, TS, 16 * ss + 8 * hi, 64 * cb + 32, 4, lane);
              S0 = __builtin_amdgcn_mfma_f32_32x32x16_bf16(vf, k0f, S0, 0, 0, 0);
              S1 = __builtin_amdgcn_mfma_f32_32x32x16_bf16(vf, k1f, S1, 0, 0, 0);
          } }
        __syncthreads();
#pragma unroll
        for (int i = 0; i < 4; ++i) {
            v2u a; a.x = pk2(S0[4 * i], S0[4 * i + 1]); a.y = pk2(S0[4 * i + 2], S0[4 * i + 3]);
            v2u c; c.x = pk2(S1[4 * i], S1[4 * i + 1]); c.y = pk2(S1[4 * i + 2], S1[4 * i + 3]);
            *(LAS v2u*)(lds + L_S + ((64 * cb + r32) * TS + 32 * vb + 8 * i + 4 * hi) * 2) = a;
            *(LAS v2u*)(lds + L_S + ((64 * cb + 32 + r32) * TS + 32 * vb + 8 * i + 4 * hi) * 2) = c;
        }
        { const int c = 32 * cb + r32;
          const float tot = (ssqL[c] + ssqL[64 + c]) + (ssqL[128 + c] + ssqL[192 + c]);
          const float rs = __builtin_amdgcn_rsqf(tot * (1.0f / 128.0f) + EPS);
          bf16* orow = QA + base + (size_t)(n * 64 + c) * 1024 + 32 * vb + 4 * hi;
#pragma unroll
          for (int i = 0; i < 4; ++i) { const f32x4 g4 = *(const LAS f32x4*)(gnL + 32 * vb + 8 * i + 4 * hi);
              v2u wv; wv.x = pk2(O[4 * i] * rs * g4[0], O[4 * i + 1] * rs * g4[1]); wv.y = pk2(O[4 * i + 2] * rs * g4[2], O[4 * i + 3] * rs * g4[3]);
              if (STORE) *(v2u*)(orow + 8 * i) = wv; else asm volatile("" :: "v"(wv.x), "v"(wv.y)); } }
    }
    __syncthreads();
}
template <bool STORE>
__device__ __forceinline__ void phase(Frame& F, const float* g_norm) {
    for (int u = F.vcu; u < 64; u += F.G) unit<STORE>(F, u >> 3, u & 7, g_norm);
}
}

namespace cmpr {
constexpr int XS = 72;
constexpr int L_X = 0, L_PART = 16 * 34 * XS * 2, L_HID = L_PART + 2 * 128 * 32 * 4, L_END = L_HID + 32 * 129 * 4;
static_assert(L_END <= RING_BYTES, "compress LDS");
__device__ __forceinline__ void unit(Frame& F, int b, int g, int which, int nq, const float* w2, const float* c1) {
    LAS unsigned char* lds = F.lds;
    const int tid = F.tid, lane = F.lane, w = F.wave, r32 = lane & 31, hi = lane >> 5, jb = w & 3, kh = w >> 2;
    const bf16* KV = (const bf16*)(F.ws + WS_KV) + (size_t)b * T * 1536 + which * 256 + g * 64;
    const bf16* W1T = (const bf16*)(F.ws + (which ? WS_WC1V : WS_WC1K));
    for (int c = tid; c < 528 * 8; c += NTHREADS) {
        const int tl = c >> 3, ch = c & 7; int tg = 512 * nq + tl; tg = tg > T - 1 ? T - 1 : tg;
        const v4u v = *(const v4u*)(KV + (size_t)tg * 1536 + ch * 8);
        *(LAS v4u*)(lds + L_X + (((tl & 15) * 34 + (tl >> 4)) * XS + ch * 8) * 2) = v;
    }
    __syncthreads();
    f32x16 acc;
#pragma unroll
    for (int r = 0; r < 16; ++r) acc[r] = 0.f;
    const bf16* wrow = W1T + (size_t)(32 * jb + r32) * 2048 + 8 * hi;
#pragma unroll 2
    for (int li = 0; li < 16; ++li) {
        const int l = 16 * kh + li;
        const int slot = (l & 15) * 34 + r32 + (l >> 4);
#pragma unroll
        for (int ks = 0; ks < 4; ++ks) {
            const bf16x8 a = *(const bf16x8*)(wrow + 64 * l + 16 * ks);
            const bf16x8 x = *(const LAS bf16x8*)(lds + L_X + (slot * XS + 16 * ks + 8 * hi) * 2);
            acc = __builtin_amdgcn_mfma_f32_32x32x16_bf16(a, x, acc, 0, 0, 0);
        }
    }
    LAS float* part = (LAS float*)(lds + L_PART);
#pragma unroll
    for (int r = 0; r < 16; ++r) part[(kh * 128 + 32 * jb + nsa::crow(r, hi)) * 32 + r32] = acc[r];
    __syncthreads();
    LAS float* hid = (LAS float*)(lds + L_HID);
    { const int n = tid & 31, j0 = (tid >> 5) * 8;
#pragma unroll
      for (int e = 0; e < 8; ++e) { const int j = j0 + e; hid[n * 129 + j] = silu(part[j * 32 + n] + part[(128 + j) * 32 + n] + c1[j]); } }
    __syncthreads();
    { const int n = tid >> 4, d4 = (tid & 15) * 4; f32x4 o = (f32x4){0.f, 0.f, 0.f, 0.f};
      for (int j = 0; j < 128; ++j) { const float hv = hid[n * 129 + j]; const f32x4 wv = *(const f32x4*)(w2 + j * 64 + d4); o += hv * wv; }
      const int ng = 32 * nq + n;
      if (ng < 127) { bf16* dst = (bf16*)(F.ws + (which ? WS_VC : WS_KC)) + ((size_t)(b * 4 + g) * 128 + ng) * 64 + d4;
          v2u wv; wv.x = pk2(o[0], o[1]); wv.y = pk2(o[2], o[3]); *(v2u*)dst = wv; } }
    __syncthreads();
}
__device__ __forceinline__ void phase(Frame& F, const float* w2k, const float* w2v) {
    const float* c1 = (const float*)(F.ws + WS_LB + 4096);
    for (int u = F.vcu; u < 256; u += F.G) { const int nq = u & 3, which = (u >> 2) & 1, g = (u >> 3) & 3, b = u >> 5;
        unit(F, b, g, which, nq, which ? w2v : w2k, c1 + which * 128); }
}
__device__ __forceinline__ void c1_prologue(Frame& F, int which, const float* pe, const float* w1) {
    LAS float* red = (LAS float*)F.lds;
    const int j = F.tid & 127, part = F.tid >> 7; float a = 0.f;
    for (int i = part * 512; i < part * 512 + 512; ++i) a += pe[i] * w1[(size_t)i * 128 + j];
    red[part * 128 + j] = a;
    __syncthreads();
    if (F.tid < 128) ((float*)(F.ws + WS_LB + 4096))[which * 128 + F.tid] = (red[F.tid] + red[128 + F.tid]) + (red[256 + F.tid] + red[384 + F.tid]);
    __syncthreads();
}
}

#ifndef MK_PER_PHASE_LAUNCH
#define MK_PER_PHASE_LAUNCH 0
#endif
constexpr int N_PHASES = 13;
struct Args { const float* in[24]; float* out; unsigned char* ws; int ph_lo, ph_hi; };

__global__ void __launch_bounds__(NTHREADS, 2) mk_fwd(Args args) {
    extern __shared__ __attribute__((aligned(16))) unsigned char lds_raw[];
    Frame F;
    F.lds = (LAS unsigned char*)lds_raw;
    F.tid = threadIdx.x; F.lane = F.tid & 63; F.wave = __builtin_amdgcn_readfirstlane(F.tid >> 6);
    F.G = gridDim.x; { const int bx = blockIdx.x; F.vcu = (F.G % 8 == 0) ? (bx % 8) * (F.G / 8) + bx / 8 : bx; }
    F.ws = args.ws; F.dout = (unsigned char*)args.out;
    volatile LAS unsigned* MISC = (volatile LAS unsigned*)(F.lds + MISC_OFF);
    for (int u = F.tid; u < (LDS_BYTES - RING_BYTES) / 4; u += NTHREADS) ((LAS unsigned*)(F.lds + RING_BYTES))[u] = 0u;
    __syncthreads();
    unsigned* ctl = (unsigned*)(F.ws + WS_CTL);
    XcdBarrier bar; bar.bar = ctl + CW_BAR; bar.x = 0; bar.st = nullptr;
    if (!MK_PER_PHASE_LAUNCH) bar = xcd_barrier_post(ctl + CW_BAR, MISC + 8);
    const int lo = args.ph_lo, hi = args.ph_hi;
#define IN(k) (lo <= (k) && (k) < hi)
#define SEAM(k) do { if (IN(k) && IN((k) + 1)) xcd_barrier(bar); } while (0)
    unsigned char* ws = F.ws;
    const float* x = args.in[0];
    float* hbuf = args.out;
    float* ss1 = (float*)(ws + CTL_SS1); float* ss2 = (float*)(ws + CTL_SS2); float* ss3 = (float*)(ws + CTL_SS3);
    const int gw = F.vcu * NWAVES + F.wave, NGW = F.G * NWAVES;

    if (IN(0)) {
        F.lane = lane_id_volatile(); F.tid = F.wave * 64 + F.lane;
        int cur = 0;
        const float* w_in = args.in[3];
        bf16* WIN = (bf16*)(ws + WS_WIN);
        transpose_job(F, w_in, INW, 1024, 0, 3072, WIN, 0, 0, cur);
        transpose_job(F, w_in, INW, 1024, 3072, 1024, WIN, 7936, 0, cur);
        transpose_job(F, w_in, INW, 1024, 4096, 2560, WIN, 3072, 0, cur);
        transpose_job(F, w_in, INW, 1024, 6656, 48, WIN, 7680, 0, cur);
        transpose_job(F, w_in, INW, 1024, 6704, 2048, WIN, 5632, 0, cur);
        transpose_job(F, args.in[12], 1024, 1024, 0, 1024, (bf16*)(ws + WS_WPR), 0, 0, cur);
        transpose_job(F, args.in[13], 1024, 1024, 0, 1024, (bf16*)(ws + WS_WPA), 0, 0, cur);
        transpose_job(F, args.in[14], 1024, 1024, 0, 1024, (bf16*)(ws + WS_WOUT), 0, 0, cur);
        transpose_job(F, args.in[17], 512, 1024, 0, 512, (bf16*)(ws + WS_WXQ), 0, 0, cur);
        transpose_job(F, args.in[18], 1024, 1024, 0, 1024, (bf16*)(ws + WS_WXKV), 0, 0, cur);
        transpose_job(F, args.in[19], 1024, 512, 0, 1024, (bf16*)(ws + WS_WXO), 0, 0, cur);
        transpose_job(F, args.in[7], 128, 2048, 0, 128, (bf16*)(ws + WS_WC1K), 0, 0, cur);
        transpose_job(F, args.in[10], 128, 2048, 0, 128, (bf16*)(ws + WS_WC1V), 0, 0, cur);
        __syncthreads();
        for (int m = gw; m < M; m += NGW) rms_row_to_bf16(x + (size_t)m * 1024, args.in[2], (bf16*)(ws + WS_A) + (size_t)m * 1024, F.lane);
        for (int m = gw; m < NB * NMEM; m += NGW) rms_row_to_bf16(args.in[1] + (size_t)m * 1024, args.in[16], (bf16*)(ws + WS_MEMN) + (size_t)m * 1024, F.lane);
        if (blockIdx.x == 1) cmpr::c1_prologue(F, 0, args.in[6], args.in[7]);
        if (blockIdx.x == 2) cmpr::c1_prologue(F, 1, args.in[9], args.in[10]);
        if (blockIdx.x == 0) { const float* lbr = args.in[4]; float* lb = (float*)(ws + WS_LB);
            for (int c = F.tid; c < 1024; c += NTHREADS) lb[c] = 1.0f / (1.0f + __expf(lbr[1024 + c] - lbr[c])); }
    }
    SEAM(0);
    if (IN(1)) {
        pg8::Gemm g{(const pg8::bf16_t*)(ws + WS_A), (const pg8::bf16_t*)(ws + WS_WIN), M, 12 * 256, 1024}; pg8::StaticOrder S; S.init(M, 12 * 256, F.G, (int)blockIdx.x);
        epi::EpiInProj E{ws, F.dout, 0};
        pg8::gemm_phase<epi::EpiInProj, pg8::StaticOrder, true, true>(F.lds, g, S, E, F.wave);
    }
    SEAM(1);
    if (IN(2)) {
        if ((int)blockIdx.x < 64) { Frame F2 = F; F2.lane = lane_id_volatile(); F2.tid = F.wave * 64 + F2.lane; F2.vcu = (int)blockIdx.x; F2.G = 64; hg::phase<true>(F2, args.in[5]); }
        else { pg8::Gemm g{(const pg8::bf16_t*)(ws + WS_A), (const pg8::bf16_t*)(ws + WS_WIN) + (size_t)12 * 256 * 1024, M, 18 * 256, 1024}; pg8::StaticOrder S; S.init(M, 18 * 256, F.G - 64, (int)blockIdx.x - 64);
          epi::EpiInProj E{ws, F.dout, 12};
          pg8::gemm_phase<epi::EpiInProj, pg8::StaticOrder, true, true>(F.lds, g, S, E, F.wave); }
    }
    SEAM(2);
    if (IN(3)) {
        { pg8::Gemm g{(const pg8::bf16_t*)(ws + WS_A), (const pg8::bf16_t*)(ws + WS_WIN) + (size_t)30 * 256 * 1024, M, 5 * 256, 1024}; pg8::StaticOrder S; S.init(M, 5 * 256, F.G, (int)blockIdx.x);
          epi::EpiInProj E{ws, F.dout, 30};
          pg8::gemm_phase<epi::EpiInProj, pg8::StaticOrder, true, true>(F.lds, g, S, E, F.wave); }
        if ((int)blockIdx.x >= 64) { Frame F2 = F; F2.lane = lane_id_volatile(); F2.tid = F.wave * 64 + F2.lane; F2.vcu = (int)blockIdx.x - 64; F2.G = F.G - 64; cmpr::phase(F2, args.in[8], args.in[11]); }
    }
    SEAM(3);
    if (IN(4)) { Frame Fp = F; Fp.lane = lane_id_volatile(); Fp.tid = F.wave * 64 + Fp.lane; nsa::phase(Fp); }
    SEAM(4);
    if (IN(5)) {
        { pg8::Gemm g{(const pg8::bf16_t*)(ws + WS_YA), (const pg8::bf16_t*)(ws + WS_WPA), M, 1024, 1024}; pg8::StaticOrder S; S.init(M, 1024, F.G, (int)blockIdx.x);
          epi::EpiGateMul E{(const unsigned short*)(F.dout + 32 * MiB), (unsigned short*)(ws + WS_MERGED), 0};
          pg8::gemm_phase<epi::EpiGateMul, pg8::StaticOrder, true, true>(F.lds, g, S, E, F.wave); }
        { pg8::Gemm g{(const pg8::bf16_t*)(ws + WS_QA), (const pg8::bf16_t*)(ws + WS_WPR), M, 1024, 1024}; pg8::StaticOrder S; S.init(M, 1024, F.G, (int)blockIdx.x);
          epi::EpiGateMul E{(const unsigned short*)(F.dout), (unsigned short*)(ws + WS_MERGED), 1};
          pg8::gemm_phase<epi::EpiGateMul, pg8::StaticOrder, true, true>(F.lds, g, S, E, F.wave); }
    }
    SEAM(5);
    if (IN(6)) {
        { pg8::Gemm g{(const pg8::bf16_t*)(ws + WS_MERGED), (const pg8::bf16_t*)(ws + WS_WOUT), M, 1024, 1024}; pg8::StaticOrder S; S.init(M, 1024, F.G, (int)blockIdx.x);
          epi::EpiResid E{x, hbuf, args.in[15], (unsigned short*)(ws + WS_A), ss1};
          pg8::gemm_phase<epi::EpiResid, pg8::StaticOrder, true, true>(F.lds, g, S, E, F.wave); }
        F.lane = lane_id_volatile(); F.tid = F.wave * 64 + F.lane;
        int cur = 0;
        transpose_job(F, args.in[21], 2 * DFF, 1024, 0, DFF, (bf16*)(ws + WS_WGU), 0, 1, cur);
        transpose_job(F, args.in[21], 2 * DFF, 1024, DFF, DFF, (bf16*)(ws + WS_WGU), 128, 1, cur);
        transpose_job(F, args.in[22], 1024, DFF, 0, 1024, (bf16*)(ws + WS_WDN), 0, 0, cur);
    }
    SEAM(6);
    if (IN(7)) {
        if ((int)blockIdx.x < 128) { pg8::Gemm g{(const pg8::bf16_t*)(ws + WS_A), (const pg8::bf16_t*)(ws + WS_WXQ), M, 512, 1024}; pg8::StaticOrder S; S.init(M, 512, 128, (int)blockIdx.x);
          epi::EpiRowScale E{ss1, (unsigned short*)(ws + WS_QX), 512, XSCALE};
          pg8::gemm_phase<epi::EpiRowScale, pg8::StaticOrder, true, true>(F.lds, g, S, E, F.wave); }
        else { pg8::Gemm g{(const pg8::bf16_t*)(ws + WS_MEMN), (const pg8::bf16_t*)(ws + WS_WXKV), NB * NMEM, 1024, 1024}; pg8::StaticOrder S; S.init(NB * NMEM, 1024, 128, (int)blockIdx.x - 128);
          epi::EpiStore E{(unsigned short*)(ws + WS_KVM), 1024};
          pg8::gemm_phase<epi::EpiStore, pg8::StaticOrder, true, true>(F.lds, g, S, E, F.wave); }
    }
    SEAM(7);
    if (IN(8)) { Frame Fp = F; Fp.lane = lane_id_volatile(); Fp.tid = F.wave * 64 + Fp.lane; xat::phase(Fp); }
    SEAM(8);
    if (IN(9)) {
        pg8::Gemm g{(const pg8::bf16_t*)(ws + WS_OX), (const pg8::bf16_t*)(ws + WS_WXO), M, 1024, 512}; pg8::StaticOrder S; S.init(M, 1024, F.G, (int)blockIdx.x);
        epi::EpiResid E{hbuf, hbuf, args.in[20], (unsigned short*)(ws + WS_QA), ss2};
        pg8::gemm_phase<epi::EpiResid, pg8::StaticOrder, true, true>(F.lds, g, S, E, F.wave);
    }
    SEAM(9);
    if (IN(10)) {
        pg8::Gemm g{(const pg8::bf16_t*)(ws + WS_QA), (const pg8::bf16_t*)(ws + WS_WGU), M, 2 * DFF, 1024}; pg8::StaticOrder S; S.init(M, 2 * DFF, F.G, (int)blockIdx.x);
        epi::EpiSwiglu E{ss2, (unsigned short*)(ws + WS_ACT)};
        pg8::gemm_phase<epi::EpiSwiglu, pg8::StaticOrder, true, true>(F.lds, g, S, E, F.wave);
    }
    SEAM(10);
    if (IN(11)) {
        pg8::Gemm g{(const pg8::bf16_t*)(ws + WS_ACT), (const pg8::bf16_t*)(ws + WS_WDN), M, 1024, DFF}; pg8::StaticOrder S; S.init(M, 1024, F.G, (int)blockIdx.x);
        epi::EpiResid E{hbuf, hbuf, nullptr, nullptr, ss3};
        pg8::gemm_phase<epi::EpiResid, pg8::StaticOrder, true, true>(F.lds, g, S, E, F.wave);
    }
    SEAM(11);
    if (IN(12)) {
        const float* gf = args.in[23]; const int lane_ = lane_id_volatile();
        for (int m = gw; m < M; m += NGW) {
            const float r = __builtin_amdgcn_rsqf(ss3[m] * (1.0f / 1024.0f) + EPS);
            GAS f32x4* hr = (GAS f32x4*)(hbuf + (size_t)m * 1024) + lane_; const GAS f32x4* gr = (const GAS f32x4*)gf + lane_;
#pragma unroll
            for (int j = 0; j < 4; ++j) { const f32x4 v = hr[64 * j], gg = gr[64 * j]; hr[64 * j] = v * r * gg; }
        }
    }
#undef IN
#undef SEAM
}

extern "C" void kernel_launch(void* const* d_in, const int* in_sizes, int n_in, void* d_out, int out_size, void* d_ws, size_t ws_size, hipStream_t stream) {
    static int grid = 0;
    if (grid == 0) {
        if (n_in != 24 || out_size != M * D || ws_size < WS_END) { fprintf(stderr, "kernel_launch: unexpected shapes (n_in %d out %d ws %zu)\n", n_in, out_size, ws_size); grid = -1; return; }
        int dev = 0, cus = 0, per_cu = 0;
        if (hipGetDevice(&dev) != hipSuccess || hipDeviceGetAttribute(&cus, hipDeviceAttributeMultiprocessorCount, dev) != hipSuccess) { grid = -1; return; }
        if (hipFuncSetAttribute((const void*)mk_fwd, hipFuncAttributeMaxDynamicSharedMemorySize, LDS_BYTES) != hipSuccess) { fprintf(stderr, "kernel_launch: hipFuncSetAttribute failed\n"); grid = -1; return; }
        if (hipOccupancyMaxActiveBlocksPerMultiprocessor(&per_cu, (const void*)mk_fwd, NTHREADS, LDS_BYTES) != hipSuccess || per_cu < 1) { fprintf(stderr, "kernel_launch: occupancy query says %d blocks per CU\n", per_cu); grid = -1; (void)hipGetLastError(); return; }
        (void)hipGetLastError();
        grid = cus;
    }
    if (grid < 0) return;
    if (hipMemsetAsync((char*)d_ws + WS_CTL, 0, CTL_ZERO_BYTES, stream) != hipSuccess) return;
    Args a{};
    for (int i = 0; i < 24; ++i) a.in[i] = (const float*)d_in[i];
    a.out = (float*)d_out; a.ws = (unsigned char*)d_ws;
#if MK_PER_PHASE_LAUNCH
    for (int p = 0; p < N_PHASES; ++p) { a.ph_lo = p; a.ph_hi = p + 1; hipLaunchKernelGGL(mk_fwd, dim3(grid), dim3(NTHREADS), LDS_BYTES, stream, a); }
#else
    a.ph_lo = 0; a.ph_hi = N_PHASES;
    hipLaunchKernelGGL(mk_fwd, dim3(grid), dim3(NTHREADS), LDS_BYTES, stream, a);
#endif
}
```
